# Optimizing an MI355X kernel written in HIP

```python
import jax, jax.numpy as jnp
from jax import lax
import numpy as np

D_MODEL = 1024
BATCH = 8
SEQ = 4096
DEPTH = 1
DEC_BATCH = 32
DEC_SEQ = 1
PAST_LEN = 16384
PAGE_SIZE = 128

MIX_WIDTH = D_MODEL
DN_HEADS = 4
DN_DK = 128
DN_DV = 128
DN_QK = DN_HEADS * DN_DK
DN_V = DN_HEADS * DN_DV
CONV_CH = 2 * DN_QK + DN_V
CONV_W = 4
DN_CHUNK = 64
AT_HEADS = 8
AT_HEAD_DIM = 64
AT_WIDTH = AT_HEADS * AT_HEAD_DIM
BRANCHES = ((128, 1), (512, 4), (2048, 16))
WINDOW = 2048
D_FF = 4 * D_MODEL
IN_SIZES = (CONV_CH, DN_V, DN_HEADS, DN_HEADS, 3 * AT_WIDTH)
IN_DIM = CONV_CH + DN_V + 2 * DN_HEADS + 3 * AT_WIDTH
EPS = 1e-6

kernel_name = 'hymba_gdn_dilated_alibi_step'


def rmsnorm(x, w):
    xf = x.astype(jnp.float32)
    y = xf * lax.rsqrt(jnp.mean(xf * xf, axis=-1, keepdims=True) + EPS) * w.astype(jnp.float32)
    return y.astype(x.dtype)


def l2norm(x):
    return x * lax.rsqrt(jnp.sum(x * x, axis=-1, keepdims=True) + EPS)


def alibi_slopes(n):
    return 2.0 ** (-8.0 * jnp.arange(1, n + 1, dtype=jnp.float32) / n)


def _to_chunks(a, nc):
    N, Tp, H = a.shape[:3]
    a = a.reshape((N, nc, DN_CHUNK, H) + a.shape[3:])
    return jnp.moveaxis(a, (1, 3), (0, 2))


def gated_delta(q, k, v, beta, g, state0):
    N, T, H, Dk = q.shape
    Dv = v.shape[-1]
    nc = -(-T // DN_CHUNK)
    Tp = nc * DN_CHUNK
    p4 = ((0, 0), (0, Tp - T), (0, 0), (0, 0))
    p3 = ((0, 0), (0, Tp - T), (0, 0))
    q = _to_chunks(jnp.pad(q, p4), nc)
    k = _to_chunks(jnp.pad(k, p4), nc)
    v = _to_chunks(jnp.pad(v, p4), nc)
    beta = _to_chunks(jnp.pad(beta, p3), nc)
    g = _to_chunks(jnp.pad(g, p3), nc)
    gc = jnp.cumsum(g, axis=-1)
    ci = jnp.arange(DN_CHUNK)
    incl = ci[:, None] >= ci[None, :]
    strict = ci[:, None] > ci[None, :]
    decay = jnp.exp(jnp.where(incl, gc[..., :, None] - gc[..., None, :], -jnp.inf))
    kb = k * beta[..., None]
    m = jnp.where(strict, jnp.einsum('...ik,...jk->...ij', kb, k) * decay, 0.0)
    a = m + jnp.eye(DN_CHUNK, dtype=m.dtype)
    rhs = jnp.concatenate([v * beta[..., None], kb * jnp.exp(gc)[..., None]], axis=-1)
    sol = lax.linalg.triangular_solve(a, rhs, left_side=True, lower=True, unit_diagonal=True)
    u, w = sol[..., :Dv], sol[..., Dv:]
    qk = jnp.where(incl, jnp.einsum('...ik,...jk->...ij', q, k) * decay, 0.0)

    def step(S, inp):
        qc, kc, uc, wc, qkc, gcc = inp
        v_new = uc - jnp.einsum('nhck,nhkv->nhcv', wc, S)
        o = (jnp.einsum('nhck,nhkv->nhcv', qc * jnp.exp(gcc)[..., None], S)
             + jnp.einsum('nhij,nhjv->nhiv', qkc, v_new))
        gl = gcc[..., -1]
        S = (S * jnp.exp(gl)[..., None, None]
             + jnp.einsum('nhck,nhcv->nhkv', kc * jnp.exp(gl[..., None] - gcc)[..., None], v_new))
        return S, o

    state, o = lax.scan(step, state0, (q, k, u, w, qk, gc))
    o = jnp.moveaxis(o, (0, 2), (1, 3)).reshape(N, Tp, H, Dv)[:, :T]
    return o, state


def banded_attention(q, k, v, slopes, dil, band):
    N, L, H, Dh = q.shape
    nb = L // band
    qb = q.reshape(N, nb, band, H, Dh)
    pad = ((0, 0), (band, 0), (0, 0), (0, 0))
    kp = jnp.pad(k, pad).reshape(N, nb + 1, band, H, Dh)
    vp = jnp.pad(v, pad).reshape(N, nb + 1, band, H, Dh)
    kw = jnp.concatenate([kp[:, :-1], kp[:, 1:]], axis=2)
    vw = jnp.concatenate([vp[:, :-1], vp[:, 1:]], axis=2)
    s = jnp.einsum('nbqhd,nbkhd->nbhqk', qb, kw).astype(jnp.float32) * (AT_HEAD_DIM ** -0.5)
    qi = jnp.arange(band)[:, None] + band
    kj = jnp.arange(2 * band)[None, :]
    dist = qi - kj
    blk = jnp.arange(nb)[:, None, None]
    mask = (dist >= 0)[None] & (dist <= band)[None] & (blk * band + kj[None] - band >= 0)
    bias = -slopes[:, None, None] * (dil * dist).astype(jnp.float32)[None]
    s = jnp.where(mask[None, :, None], s + bias[None, None], -jnp.inf)
    lse = jax.nn.logsumexp(s, axis=-1)
    p = jnp.exp(s - lse[..., None])
    o = jnp.einsum('nbhqk,nbkhd->nbqhd', p, vw.astype(jnp.float32))
    return o.reshape(N, L, H, Dh), jnp.swapaxes(lse, 2, 3).reshape(N, L, H)


def combine_branches(outs, lses):
    wts = jax.nn.softmax(jnp.stack(lses, axis=0), axis=0)
    return jnp.einsum('gnth,gnthd->nthd', wts, jnp.stack(outs, axis=0))


def dilated_attn_prompt(q, k, v, slopes):
    N, T, H, Dh = q.shape
    outs, lses = [], []
    for win, dil in BRANCHES:
        band = win // dil
        span = dil * band
        Tp = -(-T // span) * span
        Q = Tp // dil

        def to_res(a):
            a = jnp.pad(a, ((0, 0), (0, Tp - T), (0, 0), (0, 0)))
            return a.reshape(N, Q, dil, H, Dh).transpose(0, 2, 1, 3, 4).reshape(N * dil, Q, H, Dh)

        o, lse = banded_attention(to_res(q), to_res(k), to_res(v), slopes, dil, band)
        o = o.reshape(N, dil, Q, H, Dh).transpose(0, 2, 1, 3, 4).reshape(N, Tp, H, Dh)[:, :T]
        lse = lse.reshape(N, dil, Q, H).transpose(0, 2, 1, 3).reshape(N, Tp, H)[:, :T]
        outs.append(o)
        lses.append(lse)
    return combine_branches(outs, lses)


def dilated_attn_sample(q, kc, vc, L, slopes):
    T = q.shape[1]
    outs, lses = [], []
    for win, dil in BRANCHES:
        band = win // dil
        r = jnp.arange(band + 1)
        idx = L + jnp.arange(T)[:, None] - r[None, :] * dil
        valid = idx >= 0
        idxc = jnp.maximum(idx, 0)
        kg = kc[:, idxc]
        vg = vc[:, idxc]
        s = jnp.einsum('nthd,ntrhd->nthr', q, kg).astype(jnp.float32) * (AT_HEAD_DIM ** -0.5)
        s = s - slopes[:, None] * (r * dil).astype(jnp.float32)[None, :]
        s = jnp.where(valid[None, :, None, :], s, -jnp.inf)
        lse = jax.nn.logsumexp(s, axis=-1)
        p = jnp.exp(s - lse[..., None])
        outs.append(jnp.einsum('nthr,ntrhd->nthd', p, vg.astype(jnp.float32)))
        lses.append(lse)
    return combine_branches(outs, lses)


def mixer(h, conv_prev, ssm_prev, kbuf, vbuf, w_in, conv_w, a_log, dt_bias, dn_norm, w_out, prompt):
    N, T, _ = h.shape
    proj = h @ w_in
    offs = [int(o) for o in np.cumsum(IN_SIZES)[:-1]]
    dn_qkv, dn_z, dn_b, dn_a, at_qkv = jnp.split(proj, offs, axis=-1)

    xc = jnp.concatenate([conv_prev.astype(dn_qkv.dtype), dn_qkv], axis=1)
    y = xc[:, 0:T] * conv_w[0]
    for i in range(1, CONV_W):
        y = y + xc[:, i:i + T] * conv_w[i]
    y = jax.nn.silu(y).astype(jnp.float32)
    conv_new = xc[:, T:]
    qd, kd, vd = jnp.split(y, [DN_QK, 2 * DN_QK], axis=-1)
    qd = l2norm(qd.reshape(N, T, DN_HEADS, DN_DK)) * (DN_DK ** -0.5)
    kd = l2norm(kd.reshape(N, T, DN_HEADS, DN_DK))
    vd = vd.reshape(N, T, DN_HEADS, DN_DV)
    beta = jax.nn.sigmoid(dn_b.astype(jnp.float32))
    g = -jnp.exp(a_log.astype(jnp.float32)) * jax.nn.softplus(dn_a.astype(jnp.float32) + dt_bias.astype(jnp.float32))
    od, ssm_new = gated_delta(qd, kd, vd, beta, g, ssm_prev.astype(jnp.float32))
    od = od * lax.rsqrt(jnp.mean(od * od, axis=-1, keepdims=True) + EPS) * dn_norm.astype(jnp.float32)
    od = od * jax.nn.silu(dn_z.astype(jnp.float32).reshape(N, T, DN_HEADS, DN_DV))
    od = od.reshape(N, T, DN_V).astype(h.dtype)

    qa, ka, va = [a.reshape(N, T, AT_HEADS, AT_HEAD_DIM) for a in jnp.split(at_qkv, 3, axis=-1)]
    slopes = alibi_slopes(AT_HEADS)
    if prompt:
        oa = dilated_attn_prompt(qa, ka, va, slopes)
        keep = min(WINDOW, T)
        k_new, v_new = ka[:, T - keep:], va[:, T - keep:]
    else:
        L = kbuf.shape[1]
        kc = jnp.concatenate([kbuf.astype(ka.dtype), ka], axis=1)
        vc = jnp.concatenate([vbuf.astype(va.dtype), va], axis=1)
        oa = dilated_attn_sample(qa, kc, vc, L, slopes)
        keep = min(WINDOW, L + T)
        k_new, v_new = kc[:, L + T - keep:], vc[:, L + T - keep:]
    oa = oa.reshape(N, T, AT_WIDTH).astype(h.dtype)

    out = jnp.concatenate([od, oa], axis=-1) @ w_out
    return out, conv_new, ssm_new.astype(h.dtype), k_new, v_new


def forward_group(x, conv_st, ssm_st, k_st, v_st, ln_mix, w_in, dn_conv_w, dn_a_log, dn_dt_bias,
                  dn_norm, w_out, ln_ffn, w_ffn_up, w_ffn_down, ln_final, prompt):
    N = x.shape[0]
    convs, ssms, ks, vs = [], [], [], []
    for l in range(DEPTH):
        if prompt:
            conv_prev = jnp.zeros((N, CONV_W - 1, CONV_CH), x.dtype)
            ssm_prev = jnp.zeros((N, DN_HEADS, DN_DK, DN_DV), jnp.float32)
            kb = None
            vb = None
        else:
            conv_prev, ssm_prev, kb, vb = conv_st[l], ssm_st[l], k_st[l], v_st[l]
        h = rmsnorm(x, ln_mix[l])
        mix, c_new, s_new, k_new, v_new = mixer(h, conv_prev, ssm_prev, kb, vb, w_in[l], dn_conv_w[l],
                                                dn_a_log[l], dn_dt_bias[l], dn_norm[l], w_out[l], prompt)
        x = x + mix
        h = rmsnorm(x, ln_ffn[l])
        x = x + jnp.square(jax.nn.relu(h @ w_ffn_up[l])) @ w_ffn_down[l]
        convs.append(c_new)
        ssms.append(s_new)
        ks.append(k_new)
        vs.append(v_new)
    y = rmsnorm(x, ln_final)
    return y, jnp.stack(convs), jnp.stack(ssms), jnp.stack(ks), jnp.stack(vs)


def setup_inputs(seed: int = 0) -> dict:
    key = jax.random.key(seed)
    ks = jax.random.split(key, 18)
    f32 = jnp.float32
    nrm = jax.random.normal
    buf = min(WINDOW, PAST_LEN)
    dt = jnp.exp(jax.random.uniform(ks[10], (DEPTH, DN_HEADS), f32, minval=np.log(1e-3), maxval=np.log(1e-1)))
    return {
        'x_prompt': nrm(ks[0], (BATCH, SEQ, D_MODEL), f32),
        'x_sample': nrm(ks[1], (DEC_BATCH, DEC_SEQ, D_MODEL), f32),
        'state_conv': nrm(ks[2], (DEPTH, DEC_BATCH, CONV_W - 1, CONV_CH), f32),
        'state_ssm': 0.05 * nrm(ks[3], (DEPTH, DEC_BATCH, DN_HEADS, DN_DK, DN_DV), f32),
        'cache_win_k': nrm(ks[4], (DEPTH, DEC_BATCH, buf, AT_HEADS, AT_HEAD_DIM), f32),
        'cache_win_v': nrm(ks[5], (DEPTH, DEC_BATCH, buf, AT_HEADS, AT_HEAD_DIM), f32),
        'ln_mix': 1.0 + 0.02 * nrm(ks[6], (DEPTH, D_MODEL), f32),
        'w_in': nrm(ks[7], (DEPTH, D_MODEL, IN_DIM), f32) * D_MODEL ** -0.5,
        'dn_conv_w': nrm(ks[8], (DEPTH, CONV_W, CONV_CH), f32) * CONV_W ** -0.5,
        'dn_a_log': jnp.log(jax.random.uniform(ks[9], (DEPTH, DN_HEADS), f32, minval=1.0, maxval=16.0)),
        'dn_dt_bias': dt + jnp.log(-jnp.expm1(-dt)),
        'dn_norm': 1.0 + 0.02 * nrm(ks[11], (DEPTH, DN_DV), f32),
        'w_out': nrm(ks[12], (DEPTH, MIX_WIDTH, D_MODEL), f32) * MIX_WIDTH ** -0.5,
        'ln_ffn': 1.0 + 0.02 * nrm(ks[13], (DEPTH, D_MODEL), f32),
        'w_ffn_up': nrm(ks[14], (DEPTH, D_MODEL, D_FF), f32) * D_MODEL ** -0.5,
        'w_ffn_down': nrm(ks[15], (DEPTH, D_FF, D_MODEL), f32) * D_FF ** -0.5,
        'ln_final': 1.0 + 0.02 * nrm(ks[16], (D_MODEL,), f32),
    }


def reference(x_prompt, x_sample, state_conv, state_ssm, cache_win_k, cache_win_v, ln_mix, w_in,
              dn_conv_w, dn_a_log, dn_dt_bias, dn_norm, w_out, ln_ffn, w_ffn_up, w_ffn_down, ln_final):
    y_prompt, p_conv, p_ssm, p_win_k, p_win_v = forward_group(
        x_prompt, None, None, None, None, ln_mix, w_in, dn_conv_w, dn_a_log, dn_dt_bias, dn_norm,
        w_out, ln_ffn, w_ffn_up, w_ffn_down, ln_final, True)
    y_sample, s_conv, s_ssm, s_win_k, s_win_v = forward_group(
        x_sample, state_conv, state_ssm, cache_win_k, cache_win_v, ln_mix, w_in, dn_conv_w, dn_a_log,
        dn_dt_bias, dn_norm, w_out, ln_ffn, w_ffn_up, w_ffn_down, ln_final, False)
    return (y_prompt, y_sample, p_conv, p_ssm, p_win_k, p_win_v, s_conv, s_ssm, s_win_k, s_win_v)
```

```cpp
#include <hip/hip_runtime.h>
#include <cstdio>
#include <cstdint>
namespace pg8 {
#define PG8_LAS __attribute__((address_space(3)))
typedef unsigned short bf16_t;
typedef short bf16x8 __attribute__((ext_vector_type(8)));
typedef float f32x4 __attribute__((ext_vector_type(4)));
typedef unsigned u32x4 __attribute__((ext_vector_type(4)));
constexpr int BM = 256, BK = 64, HALF = 128, HTB = HALF * BK * 2  , STAGE_BYTES = 8 * HTB, NXCD = 8, WGM = 8;

__host__ __device__ __forceinline__ int lds_byte(int r, int c) { const int st = (r >> 4) * 2 + (c >> 5), rr = r & 15, cc = c & 31, ob = rr * 64 + cc * 2; return st * 1024 + (ob ^ (((ob >> 9) & 1) << 5)); }
__host__ __device__ __forceinline__ void stage_rc(int b, int& R, int& C) { const int st = b / 1024, sb = b % 1024, swz = sb ^ (((sb >> 9) & 1) << 5); R = (st >> 1) * 16 + swz / 64; C = (st & 1) * 32 + (swz % 64) / 2; }
__host__ __device__ __forceinline__ int perm32(int rho) { const int n = rho >> 4, i = rho & 15; return 8 * (i >> 2) + 4 * n + (i & 3); }

struct Unit { int pm, pn; };
struct Gemm { const bf16_t* A; const bf16_t* Bt; int M, N, K; };

struct StaticOrder {
    int nM, nN, nwg, G, c;
    __host__ __device__ void init(int M, int N, int G_, int c_) { nM = M / BM; nN = N / BM; nwg = nM * nN; G = G_; c = c_; }
    __host__ __device__ bool next(int i, Unit& u) const {
        const long L = (long)i * G + c; if (L >= nwg) return false;
        int wgid = (int)L; { const int q = nwg / NXCD, r = nwg % NXCD, xcd = wgid % NXCD, off = wgid / NXCD; wgid = (xcd < r ? xcd * (q + 1) : r * (q + 1) + (xcd - r) * q) + off; }
        const int nig = WGM * nN, gid = wgid / nig, fm = gid * WGM, gsz = (nM - fm) < WGM ? (nM - fm) : WGM;
        u.pm = fm + ((wgid % nig) % gsz); u.pn = (wgid % nig) / gsz; return true;
    }
    __device__ __forceinline__ void a_ready(const Unit&) const {}
    __device__ __forceinline__ void done(const Unit&) const {}
};

template <class Epi, class Sched, bool ALIGN_EPI = false, bool SP2 = false>
__device__ __forceinline__ void gemm_phase(PG8_LAS unsigned char* lds, const Gemm g, const Sched& S, const Epi& E) {
    const int tid = threadIdx.x, wid = __builtin_amdgcn_readfirstlane(tid >> 6), lane = tid & 63, wr = wid >> 2, wc = wid & 3, fr = lane & 15, fq = lane >> 4;
    const int K = g.K, nt = K / BK;
    unsigned voffA[2], voffB[2];
#pragma unroll
    for (int i = 0; i < 2; ++i) { int R, C; stage_rc(tid * 16 + i * 8192, R, C); const int Rb = Epi::PERM ? ((R & ~31) + perm32(R & 31)) : R;
        voffA[i] = (unsigned)(R * K + C) * 2u; voffB[i] = (unsigned)(Rb * K + C) * 2u; }
    const size_t kstep = (size_t)(BK * 2);
    const size_t hstep = (size_t)HALF * K * 2;
    const size_t tstep = 2 * hstep;
    const unsigned ldsw = (unsigned)wid * 1024u;
    const int aoff = lds_byte(wr * 64 + fr, fq * 8), boff = lds_byte(wc * 32 + fr, fq * 8);
#define PG8_SA(b, h) (((b) * 2 + (h)) * HTB)
#define PG8_SB(b, h) ((4 + (b) * 2 + (h)) * HTB)
#define PG8_STAGE(bufoff, gbase, voff) do { _Pragma("unroll") for (int _i = 0; _i < 2; ++_i) \
        __builtin_amdgcn_global_load_lds((const unsigned*)((const char*)(gbase) + (voff)[_i]), (PG8_LAS unsigned*)(lds + (bufoff) + ldsw + _i * 8192), 16, 0, 0); } while (0)
#define PG8_LDA(dst, b, h) do { _Pragma("unroll") for (int m = 0; m < 4; ++m) _Pragma("unroll") for (int k = 0; k < 2; ++k) dst[m][k] = *(const PG8_LAS bf16x8*)(lds + PG8_SA(b, h) + aoff + m * 2048 + k * 1024); } while (0)
#define PG8_LDB(dst, b, h) do { _Pragma("unroll") for (int n = 0; n < 2; ++n) _Pragma("unroll") for (int k = 0; k < 2; ++k) dst[n][k] = *(const PG8_LAS bf16x8*)(lds + PG8_SB(b, h) + boff + n * 2048 + k * 1024); } while (0)
#define PG8_MMA(ai, bj, At, Bt) do { __builtin_amdgcn_s_setprio(1); _Pragma("unroll") for (int m = 0; m < 4; ++m) _Pragma("unroll") for (int n = 0; n < 2; ++n) _Pragma("unroll") for (int k = 0; k < 2; ++k) \
        acc[ai][bj][m][n] = __builtin_amdgcn_mfma_f32_16x16x32_bf16(Bt[n][k], At[m][k], acc[ai][bj][m][n], 0, 0, 0); __builtin_amdgcn_s_setprio(0); } while (0)
#define PG8_WAIT_V(n) asm volatile("s_waitcnt vmcnt(" #n ")" ::: "memory")
#define PG8_WAIT_L(n) asm volatile("s_waitcnt lgkmcnt(" #n ")" ::: "memory")
#define PG8_BAR __builtin_amdgcn_s_barrier()
#define PG8_SCHED __builtin_amdgcn_sched_barrier(0)
    Unit cur, nxt; int ui = 0;
    if (!S.next(0, cur)) return;
    f32x4 acc[2][2][4][2];
#pragma unroll
    for (int a = 0; a < 2; ++a)
#pragma unroll
        for (int b = 0; b < 2; ++b)
#pragma unroll
            for (int m = 0; m < 4; ++m)
#pragma unroll
                for (int n = 0; n < 2; ++n) acc[a][b][m][n] = (f32x4){0.f, 0.f, 0.f, 0.f};
    bf16x8 At[4][2], B0[2][2], B1[2][2];
    const char* cA = (const char*)g.A + (size_t)cur.pm * tstep; const char* cB = (const char*)g.Bt + (size_t)cur.pn * tstep;
    S.a_ready(cur);
    if constexpr (SP2) {
        PG8_STAGE(PG8_SB(0, 0), cB, voffB); PG8_STAGE(PG8_SB(0, 1), cB + hstep, voffB); PG8_STAGE(PG8_SA(0, 0), cA, voffA); PG8_STAGE(PG8_SA(0, 1), cA + hstep, voffA);
        if (wr == 1) PG8_BAR;
        PG8_WAIT_V(2); PG8_BAR;
        PG8_STAGE(PG8_SB(1, 0), cB + kstep, voffB); PG8_STAGE(PG8_SA(1, 0), cA + kstep, voffA); PG8_STAGE(PG8_SB(1, 1), cB + hstep + kstep, voffB);
        PG8_WAIT_V(6); PG8_BAR;
    } else {
        PG8_STAGE(PG8_SB(0, 0), cB, voffB); PG8_STAGE(PG8_SA(0, 0), cA, voffA); PG8_STAGE(PG8_SB(0, 1), cB + hstep, voffB); PG8_STAGE(PG8_SA(0, 1), cA + hstep, voffA);
        if (wr == 1) PG8_BAR;
        PG8_WAIT_V(4); PG8_BAR;
        PG8_STAGE(PG8_SB(1, 0), cB + kstep, voffB); PG8_STAGE(PG8_SA(1, 0), cA + kstep, voffA); PG8_STAGE(PG8_SB(1, 1), cB + hstep + kstep, voffB);
        PG8_WAIT_V(6); PG8_BAR;
    }
    for (;;) {
        const bool has_next = S.next(ui + 1, nxt);
        const char* nA = has_next ? (const char*)g.A + (size_t)nxt.pm * tstep : cA; const char* nB = has_next ? (const char*)g.Bt + (size_t)nxt.pn * tstep : cB;
        for (int t = 0; t < nt; t += 2) {
            const bool last = (t == nt - 2);
            const char* a1 = cA + (size_t)(t + 1) * kstep;
            const char* a2 = last ? nA : cA + (size_t)(t + 2) * kstep; const char* b2 = last ? nB : cB + (size_t)(t + 2) * kstep;
            const char* a3 = a2 + kstep; const char* b3 = b2 + kstep;
            if (last && has_next) S.a_ready(nxt);
            if constexpr (SP2) {
            PG8_LDB(B0, 0, 0); PG8_LDB(B1, 0, 1); PG8_SCHED; PG8_LDA(At, 0, 0); PG8_STAGE(PG8_SA(1, 1), a1 + hstep, voffA);
            PG8_WAIT_V(8); PG8_WAIT_L(0); PG8_BAR; PG8_MMA(0, 0, At, B0); PG8_MMA(0, 1, At, B1); PG8_BAR; PG8_SCHED;
            PG8_LDA(At, 0, 1); PG8_STAGE(PG8_SB(0, 0), b2, voffB); PG8_STAGE(PG8_SB(0, 1), b2 + hstep, voffB); PG8_STAGE(PG8_SA(0, 0), a2, voffA);
            PG8_WAIT_V(8); PG8_WAIT_L(0); PG8_BAR; PG8_MMA(1, 0, At, B0); PG8_MMA(1, 1, At, B1); PG8_BAR; PG8_SCHED;
            PG8_LDB(B0, 1, 0); PG8_LDB(B1, 1, 1); PG8_SCHED; PG8_LDA(At, 1, 0); PG8_STAGE(PG8_SA(0, 1), a2 + hstep, voffA);
            PG8_WAIT_V(8); PG8_WAIT_L(0); PG8_BAR; PG8_MMA(0, 0, At, B0); PG8_MMA(0, 1, At, B1); PG8_BAR; PG8_SCHED;
            PG8_LDA(At, 1, 1); PG8_STAGE(PG8_SB(1, 0), b3, voffB); PG8_STAGE(PG8_SB(1, 1), b3 + hstep, voffB); PG8_STAGE(PG8_SA(1, 0), a3, voffA);
            PG8_WAIT_V(8); PG8_WAIT_L(0); PG8_BAR; PG8_MMA(1, 0, At, B0); PG8_MMA(1, 1, At, B1); PG8_BAR; PG8_SCHED;
            } else {
            PG8_LDB(B0, 0, 0); PG8_SCHED; PG8_LDA(At, 0, 0); PG8_STAGE(PG8_SA(1, 1), a1 + hstep, voffA);
            PG8_WAIT_L(8); PG8_BAR; PG8_WAIT_L(0); PG8_MMA(0, 0, At, B0); PG8_BAR; PG8_SCHED;
            PG8_LDB(B1, 0, 1); PG8_STAGE(PG8_SB(0, 0), b2, voffB);
            PG8_BAR; PG8_WAIT_L(0); PG8_MMA(0, 1, At, B1); PG8_BAR;
            PG8_LDA(At, 0, 1); PG8_STAGE(PG8_SA(0, 0), a2, voffA);
            PG8_BAR; PG8_WAIT_L(0); PG8_MMA(1, 0, At, B0); PG8_BAR; PG8_SCHED;
            PG8_STAGE(PG8_SB(0, 1), b2 + hstep, voffB);
            PG8_WAIT_V(6); PG8_BAR; PG8_MMA(1, 1, At, B1); PG8_BAR;
            PG8_LDB(B0, 1, 0); PG8_SCHED; PG8_LDA(At, 1, 0); PG8_STAGE(PG8_SA(0, 1), a2 + hstep, voffA);
            PG8_WAIT_L(8); PG8_BAR; PG8_WAIT_L(0); PG8_MMA(0, 0, At, B0); PG8_BAR; PG8_SCHED;
            PG8_LDB(B1, 1, 1); PG8_STAGE(PG8_SB(1, 0), b3, voffB);
            PG8_BAR; PG8_WAIT_L(0); PG8_MMA(0, 1, At, B1); PG8_BAR;
            PG8_LDA(At, 1, 1); PG8_STAGE(PG8_SA(1, 0), a3, voffA);
            PG8_BAR; PG8_WAIT_L(0); PG8_MMA(1, 0, At, B0); PG8_BAR; PG8_SCHED;
            PG8_STAGE(PG8_SB(1, 1), b3 + hstep, voffB);
            PG8_WAIT_V(6); PG8_BAR; PG8_MMA(1, 1, At, B1); PG8_BAR;
            }
        }
        if constexpr (ALIGN_EPI) { if (wr == 0) PG8_BAR; }
        if constexpr (!Epi::AFTER_DRAIN) { E(acc, cur, wr, wc, fr, fq); S.done(cur); }
        if (!has_next) break;
#pragma unroll
        for (int a = 0; a < 2; ++a)
#pragma unroll
            for (int b = 0; b < 2; ++b)
#pragma unroll
                for (int m = 0; m < 4; ++m)
#pragma unroll
                    for (int n = 0; n < 2; ++n) acc[a][b][m][n] = (f32x4){0.f, 0.f, 0.f, 0.f};
        cur = nxt; cA = nA; cB = nB; ++ui;
        if constexpr (ALIGN_EPI) { if (wr == 1) PG8_BAR; }
    }
    PG8_WAIT_V(0);
    if constexpr (!ALIGN_EPI) { if (wr == 0) PG8_BAR; }
    PG8_BAR;
    if constexpr (Epi::AFTER_DRAIN) { E.fused(acc, cur, wr, wc, fr, fq, lds, wid, lane); S.done(cur); }
#undef PG8_SA
#undef PG8_SB
#undef PG8_STAGE
#undef PG8_LDA
#undef PG8_LDB
#undef PG8_MMA
#undef PG8_WAIT_V
#undef PG8_WAIT_L
#undef PG8_BAR
#undef PG8_SCHED
}
}
#define LAS __attribute__((address_space(3)))
#define XB_TMO      128
#define XB_XCNT(j)  (256  + 64 * (j))
#define XB_XSUB(j)  (1280 + 64 * (j))
#define XB_XGEN(j)  (2304 + 64 * (j))
#define XB_TOP      3328
#define XB_TOPGEN   3392
#define XCD_BAR_WORDS 3456
#define XB_SPIN_CAP (1u << 18)

__device__ __forceinline__ unsigned xb_ld(unsigned* p)              { return __hip_atomic_load(p, __ATOMIC_RELAXED, __HIP_MEMORY_SCOPE_AGENT); }
__device__ __forceinline__ unsigned xb_add(unsigned* p, unsigned v) { return __hip_atomic_fetch_add(p, v, __ATOMIC_RELAXED, __HIP_MEMORY_SCOPE_AGENT); }
__device__ __forceinline__ unsigned xb_xcc_id() { return (unsigned)__builtin_amdgcn_s_getreg((3 << 11) | 20) & 0xFu; }
#define XB_SPIN(cond, bar) do { unsigned _sp = 0; while (cond) { __builtin_amdgcn_s_sleep(1); \
    if ((++_sp & 255u) == 0u) { if (xb_ld(&(bar)[XB_TMO])) break; if (_sp > XB_SPIN_CAP) { atomicAdd(&(bar)[XB_TMO], 1u); break; } } } } while (0)

struct XcdBarrier {
    unsigned* bar; unsigned x;
    volatile LAS unsigned* st;
};

__device__ __forceinline__ XcdBarrier xcd_barrier_post(unsigned* bar, volatile LAS unsigned* st) {
    XcdBarrier b; b.bar = bar; b.x = xb_xcc_id(); b.st = st;
    if (threadIdx.x == 0) (void)xb_add(&bar[XB_XCNT(b.x)], 1u);
    return b;
}
__device__ __forceinline__ void xcd_barrier_complete(unsigned* bar, unsigned x, unsigned& nloc, unsigned& nx) {
    const unsigned G = gridDim.x * gridDim.y * gridDim.z;
    unsigned sum, cnt, mine, sp = 0u;
    for (;;) {
        sum = 0u; cnt = 0u; mine = 0u;
#pragma unroll
        for (unsigned j = 0; j < 16; ++j) { const unsigned c = xb_ld(&bar[XB_XCNT(j)]); sum += c; cnt += (c > 0u) ? 1u : 0u; mine = (j == x) ? c : mine; }
        if (sum == G) break;
        __builtin_amdgcn_s_sleep(1);
        if ((++sp & 255u) == 0u) { if (xb_ld(&bar[XB_TMO])) break; if (sp > XB_SPIN_CAP) { atomicAdd(&bar[XB_TMO], 1u); break; } }
    }
    nloc = mine > 0u ? mine : 1u; nx = cnt > 0u ? cnt : 1u;
}

__device__ __forceinline__ void xcd_barrier(const XcdBarrier& b) {
    asm volatile("s_waitcnt vmcnt(0)" ::: "memory");
    __syncthreads();
    if (threadIdx.x == 0) {
        unsigned* bar = b.bar;
        __builtin_amdgcn_s_waitcnt(0);
        unsigned nloc = b.st[0], nx = b.st[1];
        if (nloc == 0u) { xcd_barrier_complete(bar, b.x, nloc, nx); b.st[0] = nloc; b.st[1] = nx; }
        const unsigned old = xb_add(&bar[XB_XSUB(b.x)], 1u);
        const unsigned gen = old / nloc;
        if (old + 1u == (gen + 1u) * nloc) {
            __builtin_amdgcn_fence(__ATOMIC_RELEASE, "agent");
            asm volatile("s_waitcnt vmcnt(0)" ::: "memory");
            const unsigned og = xb_add(&bar[XB_TOP], 1u);
            const unsigned tg = og / nx, goal = (tg + 1u) * nx;
            if (og + 1u != goal) XB_SPIN(xb_ld(&bar[XB_TOP]) < goal, bar);
            xb_add(&bar[XB_XGEN(b.x)], 1u);
            __builtin_amdgcn_fence(__ATOMIC_ACQUIRE, "agent");
            asm volatile("s_waitcnt vmcnt(0)" ::: "memory");
        } else {
            XB_SPIN(xb_ld(&bar[XB_XGEN(b.x)]) == gen, bar);
            __builtin_amdgcn_fence(__ATOMIC_ACQUIRE, "agent");
            asm volatile("s_waitcnt vmcnt(0)" ::: "memory");
        }
    }
    __syncthreads();
}
#undef LAS

#define GAS __attribute__((address_space(1)))
#define LAS __attribute__((address_space(3)))
using pg8::bf16_t; using pg8::bf16x8; using pg8::f32x4; using pg8::u32x4;
typedef float f32x16 __attribute__((ext_vector_type(16)));
typedef float f32x2 __attribute__((ext_vector_type(2)));
typedef unsigned u32x2 __attribute__((ext_vector_type(2)));
typedef short s16x4 __attribute__((ext_vector_type(4)));

constexpr int NWAVES = 8, NTHREADS = 512;
constexpr int D = 1024, NB = 8, SEQ = 4096, M = NB * SEQ, SB = 32;
constexpr int CONV_CH = 1536, NHD = 4, DK = 128, DV = 128, ATH = 8, ATD = 64, ATW = 512;
constexpr int IN_DIM = 3592, NIN = 3584, FF = 4096, WIN = 2048, NCH = SEQ / 64;
constexpr float EPS = 1e-6f;
constexpr float LOG2E = 1.4426950408889634f;
constexpr float QSCALE = 0.125f * LOG2E;

constexpr size_t O_Y = 0, O_YS = 33554432, O_PCONV = 33587200, O_PSSM = 33624064, O_PWK = 34148352, O_PWV = 42536960,
                 O_SCONV = 50925568, O_SSSM = 51073024, O_SWK = 53170176, O_SWV = 86724608, O_END = 120279040;

constexpr size_t MiB = 1u << 20;
constexpr size_t WS_CTL = 0, CTL_ZERO_BYTES = 128 * 1024;
constexpr size_t WS_WIN = 2 * MiB, WS_WOUT = 10 * MiB, WS_WUP = 12 * MiB, WS_WDN = 20 * MiB;
constexpr size_t WS_BETA = 28 * MiB, WS_GG = WS_BETA + 512 * 1024, WS_EGL = 29 * MiB;
constexpr size_t WS_SSQ1 = 30 * MiB, WS_SSQ2 = 32 * MiB, WS_LSE = 34 * MiB;
constexpr size_t WS_S = 37 * MiB;
constexpr size_t WS_XSN = WS_S, WS_SGATE = WS_S + 64 * 1024, WS_SPROJ = WS_S + 128 * 1024, WS_SMIX = WS_S + 640 * 1024,
                 WS_XS1 = WS_S + 704 * 1024, WS_SH = WS_S + 832 * 1024, WS_XS2 = WS_S + 1088 * 1024, WS_SATT = WS_S + 1280 * 1024;
constexpr size_t WS_SPART = 39 * MiB;
constexpr size_t WS_XN = 40 * MiB;
constexpr size_t WS_O1 = 40 * MiB, WS_O2 = 72 * MiB, WS_X1B = 40 * MiB;
constexpr size_t WS_PRE = 104 * MiB;
constexpr size_t WS_MIX = 104 * MiB, WS_H = 104 * MiB;
constexpr size_t WS_Z = 200 * MiB;
constexpr size_t WS_QA = 232 * MiB, WS_KA = 264 * MiB, WS_VA = 296 * MiB;
constexpr size_t WS_ORAW = 168 * MiB;
constexpr size_t WS_GDN = 328 * MiB;
constexpr size_t WS_O3 = 472 * MiB;
constexpr size_t WS_END = 504 * MiB;
constexpr int GDN_CHUNK_BYTES = 73728;
constexpr int GI_NW = 0, GI_QG = 16384, GI_QK = 32768, GI_KD = 40960, GI_U = 57344;

constexpr int CW_TMO = 0, CW_BAR = 4096, CW_PANEL = 16384;

constexpr int RING_BYTES = 131072, LDSCTL_OFF = 159744, MISC_OFF = LDSCTL_OFF + 320, LDS_BYTES = 160768;

#define LDS_WAIT() asm volatile("s_waitcnt lgkmcnt(0)" ::: "memory")
#define VM_WAIT() asm volatile("s_waitcnt vmcnt(0)" ::: "memory")

__device__ __forceinline__ unsigned pkbf(float lo, float hi) {
    typedef __bf16 bf2_t __attribute__((ext_vector_type(2)));
    f32x2 v = {lo, hi}; bf2_t b = __builtin_convertvector(v, bf2_t); return __builtin_bit_cast(unsigned, b);
}
__device__ __forceinline__ float bflo(unsigned u) { return __uint_as_float(u << 16); }
__device__ __forceinline__ float bfhi(unsigned u) { return __uint_as_float(u & 0xffff0000u); }
__device__ __forceinline__ float wave_sum(float v) {
#pragma unroll
    for (int o = 1; o < 64; o <<= 1) v += __shfl_xor(v, o);
    return v;
}
__device__ __forceinline__ float siluf(float x) { return x * __builtin_amdgcn_rcpf(1.f + __expf(-x)); }
__device__ __forceinline__ float sigmoidf_(float x) { return 1.f / (1.f + __expf(-x)); }
__device__ __forceinline__ float softplusf_(float x) { return x > 20.f ? x : log1pf(__expf(x)); }


struct Ctx {
    LAS unsigned char* lds;
    int tid, lane, wave, G, bid;
    const float *x, *xs, *st_conv, *st_ssm, *ck, *cv, *ln_mix, *w_in, *conv_w, *a_log, *dt_bias, *dn_norm, *w_out, *ln_ffn, *w_up, *w_dn, *ln_final;
    float* out; unsigned char* ws;
};
#define WSP(T, off) ((T*)(C.ws + (off)))

__device__ __forceinline__ void transpose_item(const float* __restrict__ W, int ldw, int srccol0, int k0, const float* __restrict__ kscale, bf16_t* WT, int K, int dstrow0, LAS float* scr, int lane) {
    float tv[32];
#pragma unroll
    for (int i = 0; i < 32; ++i) tv[i] = W[(size_t)(k0 + 2 * i + (lane >> 5)) * ldw + srccol0 + (lane & 31)];
#pragma unroll
    for (int i = 0; i < 32; ++i) { const int kk = 2 * i + (lane >> 5); float v = tv[i]; if (kscale) v *= kscale[k0 + kk]; scr[kk * 33 + (lane & 31)] = v; }
    LDS_WAIT(); asm volatile("" ::: "memory");
    const int c = lane & 7;
#pragma unroll
    for (int j = 0; j < 4; ++j) { const int n = (lane >> 3) + 8 * j; const LAS float* s = scr + (8 * c) * 33 + n;
        u32x4 o; o.x = pkbf(s[0 * 33], s[1 * 33]); o.y = pkbf(s[2 * 33], s[3 * 33]); o.z = pkbf(s[4 * 33], s[5 * 33]); o.w = pkbf(s[6 * 33], s[7 * 33]);
        *(u32x4*)(WT + (size_t)(dstrow0 + n) * K + k0 + 8 * c) = o; }
    LDS_WAIT(); asm volatile("" ::: "memory");
}

__device__ __forceinline__ void late_weight_copies(Ctx& C, int part, int nparts) {
    const int gw = part * NWAVES + C.wave, NGW = nparts * NWAVES, lane = C.lane;
    LAS float* scr = (LAS float*)(C.lds + C.wave * 16384);
    constexpr int I_OUT = (D / 64) * (D / 32), I_UP = (D / 64) * (FF / 32), I_DN = (FF / 64) * (D / 32);
    for (int it = gw; it < I_OUT + I_UP + I_DN; it += NGW) {
        const int q9 = it / 9, m9 = it % 9;
        if (m9 == 0) { const int r = q9; const int nblk = D / 32, kb = r / nblk, nb = r % nblk;
            transpose_item(C.w_out, D, nb * 32, 64 * kb, nullptr, WSP(bf16_t, WS_WOUT), D, nb * 32, scr, lane); }
        else if (m9 < 5) { const int r = q9 * 4 + (m9 - 1); const int nblk = FF / 32, kb = r / nblk, nb = r % nblk;
            transpose_item(C.w_up, FF, nb * 32, 64 * kb, C.ln_ffn, WSP(bf16_t, WS_WUP), D, nb * 32, scr, lane); }
        else { const int r = q9 * 4 + (m9 - 5); const int nblk = D / 32, kb = r / nblk, nb = r % nblk;
            transpose_item(C.w_dn, D, nb * 32, 64 * kb, nullptr, WSP(bf16_t, WS_WDN), FF, nb * 32, scr, lane); }
    }
    __syncthreads();
}
__device__ __forceinline__ void p0_prologue(Ctx& C) {
    const int gw = C.bid * NWAVES + C.wave, NGW = C.G * NWAVES, lane = C.lane;
    {
        LAS float* scr = (LAS float*)(C.lds + C.wave * 16384);
        constexpr int I_IN = (D / 64) * (NIN / 32);
        for (int it = gw; it < I_IN; it += NGW) { const int nblk = NIN / 32, kb = it / nblk, nb = it % nblk; const int src = nb * 32 + (nb >= 64 ? 8 : 0);
            transpose_item(C.w_in, IN_DIM, src, 64 * kb, nullptr, WSP(bf16_t, WS_WIN), D, nb * 32, scr, lane); }
    }
    __syncthreads();
    LAS float* wg = (LAS float*)C.lds;
    for (int idx = C.tid; idx < 8192; idx += NTHREADS) { const int k = idx >> 3, g = idx & 7; wg[g * 1024 + k] = C.w_in[(size_t)k * IN_DIM + 2048 + g]; }
    __syncthreads();
    f32x4 lw[4];
#pragma unroll
    for (int j = 0; j < 4; ++j) lw[j] = ((const f32x4*)C.ln_mix)[64 * j + lane];
    bf16_t* XN = WSP(bf16_t, WS_XN); bf16_t* XSN = WSP(bf16_t, WS_XSN);
    float* BETA = WSP(float, WS_BETA); float* GG = WSP(float, WS_GG); float* SG = WSP(float, WS_SGATE);
    for (int row = gw; row < M + SB; row += NGW) {
        const bool smp = row >= M;
        const float* xr = smp ? C.xs + (size_t)(row - M) * D : C.x + (size_t)row * D;
        f32x4 v[4]; float s = 0.f;
#pragma unroll
        for (int j = 0; j < 4; ++j) { v[j] = ((const f32x4*)xr)[64 * j + lane]; s += (v[j].x * v[j].x + v[j].y * v[j].y) + (v[j].z * v[j].z + v[j].w * v[j].w); }
        s = wave_sum(s);
        const float rstd = rsqrtf(s * (1.f / D) + EPS);
#pragma unroll
        for (int j = 0; j < 4; ++j) v[j] = v[j] * rstd * lw[j];
        bf16_t* orow = smp ? XSN + (size_t)(row - M) * D : XN + (size_t)row * D;
#pragma unroll
        for (int j = 0; j < 4; ++j) { u32x2 o; o.x = pkbf(v[j].x, v[j].y); o.y = pkbf(v[j].z, v[j].w); ((u32x2*)orow)[64 * j + lane] = o; }
        float a[8];
#pragma unroll
        for (int g = 0; g < 8; ++g) { float t = 0.f;
#pragma unroll
            for (int j = 0; j < 4; ++j) { const f32x4 w = ((const LAS f32x4*)wg)[g * 256 + 64 * j + lane]; t += (v[j].x * w.x + v[j].y * w.y) + (v[j].z * w.z + v[j].w * w.w); }
            a[g] = t; }
        { const bool hi = lane & 1;
#pragma unroll
          for (int i = 0; i < 4; ++i) { const float keep = hi ? a[i + 4] : a[i], send = hi ? a[i] : a[i + 4]; a[i] = keep + __shfl_xor(send, 1); } }
        { const bool hi = lane & 2;
#pragma unroll
          for (int i = 0; i < 2; ++i) { const float keep = hi ? a[i + 2] : a[i], send = hi ? a[i] : a[i + 2]; a[i] = keep + __shfl_xor(send, 2); } }
        { const bool hi = lane & 4; const float keep = hi ? a[1] : a[0], send = hi ? a[0] : a[1]; a[0] = keep + __shfl_xor(send, 4); }
        float gv = a[0]; gv += __shfl_xor(gv, 8); gv += __shfl_xor(gv, 16); gv += __shfl_xor(gv, 32);
        if (lane < 8) {
            const int gi = 4 * (lane & 1) + 2 * ((lane >> 1) & 1) + ((lane >> 2) & 1);
            float o;
            if (gi < 4) o = sigmoidf_(gv);
            else { const int h = gi - 4; o = -__expf(C.a_log[h]) * softplusf_(gv + C.dt_bias[h]); }
            if (smp) SG[(row - M) * 8 + gi] = o;
            else if (gi < 4) BETA[(size_t)row * 4 + gi] = o; else GG[(size_t)row * 4 + (gi - 4)] = o;
        }
    }
    __syncthreads();
}

template <class ALoad, class Epi>
__device__ __forceinline__ void sgemm32_part(int n0, int kb, int kl, int ldw, const bf16_t* __restrict__ WT, const ALoad& AL, const Epi& E, LAS float* red, int tid) {
    const int lane = tid & 63, wave = tid >> 6, r = lane & 31, h = lane >> 5; const int ks = kl / 8, k0 = kb + wave * ks;
    f32x16 acc;
#pragma unroll
    for (int i = 0; i < 16; ++i) acc[i] = 0.f;
    const bf16_t* wrow = WT + (size_t)(n0 + r) * ldw + k0 + 8 * h;
    for (int k = 0; k < ks; k += 16) { const bf16x8 a = AL(r, k0 + k + 8 * h); const bf16x8 b = *(const bf16x8*)(wrow + k); acc = __builtin_amdgcn_mfma_f32_32x32x16_bf16(a, b, acc, 0, 0, 0); }
#pragma unroll
    for (int i = 0; i < 16; ++i) red[wave * 1024 + i * 64 + lane] = acc[i];
    __syncthreads();
#pragma unroll
    for (int q = 0; q < 2; ++q) { const int e = tid + q * 512; float s = 0.f;
#pragma unroll
        for (int w = 0; w < 8; ++w) s += red[w * 1024 + e];
        const int reg = e >> 6, l = e & 63; E((reg & 3) + 8 * (reg >> 2) + 4 * (l >> 5), n0 + (l & 31), s); }
    __syncthreads();
}
template <class ALoad, class Epi>
__device__ __forceinline__ void sgemm32_item(int n0, int K, const bf16_t* __restrict__ WT, const ALoad& AL, const Epi& E, LAS float* red, int tid) { sgemm32_part(n0, 0, K, K, WT, AL, E, red, tid); }
struct ALoadBf16 { const bf16_t* A; int ld; __device__ __forceinline__ bf16x8 operator()(int row, int k) const { return *(const bf16x8*)(A + (size_t)row * ld + k); } };
struct ALoadF32 { const float* A; int ld;
    __device__ __forceinline__ bf16x8 operator()(int row, int k) const { const f32x4 a = *(const f32x4*)(A + (size_t)row * ld + k), b = *(const f32x4*)(A + (size_t)row * ld + k + 4);
        u32x4 o; o.x = pkbf(a.x, a.y); o.y = pkbf(a.z, a.w); o.z = pkbf(b.x, b.y); o.w = pkbf(b.z, b.w); return __builtin_bit_cast(bf16x8, o); } };

struct EpiIn {
    static constexpr bool PERM = true, AFTER_DRAIN = false;
    bf16_t *PRE, *Z, *QA, *KA, *VA; float* out;
    __device__ __forceinline__ void operator()(const f32x4 (&acc)[2][2][4][2], const pg8::Unit& u, int wr, int wc, int fr, int fq) const {
        const int pn = u.pn, pm = u.pm;
        bf16_t* base; int ldc, coff; float sc = 1.f;
        if (pn < 6) { base = PRE; ldc = CONV_CH; coff = pn * 256; }
        else if (pn < 8) { base = Z; ldc = 512; coff = (pn - 6) * 256; }
        else if (pn < 10) { base = QA; ldc = 512; coff = (pn - 8) * 256; sc = QSCALE; }
        else if (pn < 12) { base = KA; ldc = 512; coff = (pn - 10) * 256; }
        else { base = VA; ldc = 512; coff = (pn - 12) * 256; }
        const int row0 = pm * 256 + wr * 64 + fr, col0 = coff + wc * 32 + 8 * fq;
#pragma unroll
        for (int ai = 0; ai < 2; ++ai)
#pragma unroll
            for (int m = 0; m < 4; ++m) { bf16_t* rowp = base + (size_t)(row0 + ai * 128 + m * 16) * ldc + col0;
#pragma unroll
                for (int bj = 0; bj < 2; ++bj) { const f32x4 v0 = acc[ai][bj][m][0] * sc, v1 = acc[ai][bj][m][1] * sc;
                    u32x4 w; w.x = pkbf(v0[0], v0[1]); w.y = pkbf(v0[2], v0[3]); w.z = pkbf(v1[0], v1[1]); w.w = pkbf(v1[2], v1[3]);
                    *(u32x4*)(rowp + bj * 128) = w; } }
        if (pn >= 10 && (pm & 15) >= 8) {
            float* o = out + (pn < 12 ? O_PWK : O_PWV) + (size_t)((pm >> 4) * WIN + ((pm & 15) - 8) * 256 + wr * 64 + fr) * ATW + col0;
#pragma unroll
            for (int ai = 0; ai < 2; ++ai)
#pragma unroll
                for (int m = 0; m < 4; ++m)
#pragma unroll
                    for (int bj = 0; bj < 2; ++bj) { float* p = o + (size_t)(ai * 128 + m * 16) * ATW + bj * 128; *(f32x4*)p = acc[ai][bj][m][0]; *(f32x4*)(p + 4) = acc[ai][bj][m][1]; }
        }
        if (pn < 6 && (pm & 15) == 15 && wr == 1 && fr >= 13) {
            float* o = out + O_PCONV + (size_t)((pm >> 4) * 3 + (fr - 13)) * CONV_CH + col0;
#pragma unroll
            for (int bj = 0; bj < 2; ++bj) { *(f32x4*)(o + bj * 128) = acc[1][bj][3][0]; *(f32x4*)(o + bj * 128 + 4) = acc[1][bj][3][1]; }
        }
    }
};
__device__ __forceinline__ void p1_inproj(Ctx& C) {
    pg8::Gemm g{WSP(bf16_t, WS_XN), WSP(bf16_t, WS_WIN), M, NIN, D}; pg8::StaticOrder S; S.init(M, NIN, C.G, C.bid);
    EpiIn E{WSP(bf16_t, WS_PRE), WSP(bf16_t, WS_Z), WSP(bf16_t, WS_QA), WSP(bf16_t, WS_KA), WSP(bf16_t, WS_VA), C.out};
    pg8::gemm_phase<EpiIn, pg8::StaticOrder, true, true>(C.lds, g, S, E);
    float* SPROJ = WSP(float, WS_SPROJ);
    const ALoadBf16 AL{WSP(bf16_t, WS_XSN), D};
    auto Ep = [SPROJ](int row, int col, float v) { SPROJ[row * NIN + col] = v; };
    for (int it = C.bid; it < NIN / 32; it += C.G) sgemm32_item(it * 32, D, WSP(bf16_t, WS_WIN), AL, Ep, (LAS float*)C.lds, C.tid);
}

typedef short v4i16_t __attribute__((ext_vector_type(4)));
__device__ __forceinline__ s16x4 tr16(const LAS unsigned char* p) { return __builtin_bit_cast(s16x4, __builtin_amdgcn_ds_read_tr16_b64_v4i16((LAS v4i16_t*)p)); }
typedef float f32x4_t __attribute__((ext_vector_type(4)));

struct AttnItem { int n, h, g, d, rho, B; };
__device__ __forceinline__ AttnItem attn_decode(int item) {
    AttnItem a; const int nh = item / 96, j = item % 96; a.n = nh >> 3; a.h = nh & 7;
    if (j < 32) { a.g = 0; a.d = 1; a.rho = 0; a.B = j; } else if (j < 64) { a.g = 1; a.d = 4; a.rho = (j - 32) >> 3; a.B = (j - 32) & 7; } else { a.g = 2; a.d = 16; a.rho = (j - 64) >> 1; a.B = (j - 64) & 1; }
    return a;
}
struct AttnPre { u32x4 k[4], v[4]; bf16x8 q0, q1; };
__device__ __forceinline__ void attn_prefetch(Ctx& C, const AttnItem& a, AttnPre& P) {
    const bf16_t* QA = WSP(bf16_t, WS_QA); const bf16_t* KA = WSP(bf16_t, WS_KA); const bf16_t* VA = WSP(bf16_t, WS_VA);
    const size_t seq0 = (size_t)a.n * SEQ;
#pragma unroll
    for (int q = 0; q < 4; ++q) { const int ci = C.tid + 512 * q, kl = ci >> 3, c = ci & 7; int sub = 128 * (a.B - 1) + kl; sub = sub < 0 ? 0 : sub;
        const size_t src = (seq0 + a.rho + (size_t)a.d * sub) * 512 + a.h * 64 + c * 8;
        P.k[q] = *(const u32x4*)(KA + src); P.v[q] = *(const u32x4*)(VA + src); }
    const int i = C.lane & 15, G = C.lane >> 4;
    const size_t qrow = seq0 + a.rho + (size_t)a.d * (128 * a.B + 16 * C.wave + i);
    P.q0 = *(const bf16x8*)(QA + qrow * 512 + a.h * 64 + 8 * G); P.q1 = *(const bf16x8*)(QA + qrow * 512 + a.h * 64 + 32 + 8 * G);
}
__device__ __forceinline__ void attn_stage(LAS unsigned char* buf, const AttnPre& P, int tid) {
#pragma unroll
    for (int q = 0; q < 4; ++q) { const int ci = tid + 512 * q, kl = ci >> 3, c = ci & 7;
        *(LAS u32x4*)(buf + kl * 128 + 16 * (c ^ ((kl >> 1) & 7))) = P.k[q];
        *(LAS u32x4*)(buf + 32768 + kl * 128 + 16 * (c ^ (((kl >> 1) & 3) << 1))) = P.v[q]; }
}
__device__ __forceinline__ void attn_compute(Ctx& C, const AttnItem& a, const LAS unsigned char* buf, const bf16x8 qf0, const bf16x8 qf1) {
    bf16_t* OG = WSP(bf16_t, a.g == 0 ? WS_O1 : (a.g == 1 ? WS_O2 : WS_O3)); float* LSE = WSP(float, WS_LSE) + (size_t)a.g * M * 8;
    const int lane = C.lane, w = C.wave, i = lane & 15, G = lane >> 4;
    const LAS unsigned char* Ks = buf; const LAS unsigned char* Vs = buf + 32768;
    const size_t qrow = (size_t)a.n * SEQ + a.rho + (size_t)a.d * (128 * a.B + 16 * w + i);
    const float slope2 = exp2f(-(float)(a.h + 1)) * (float)a.d * LOG2E;
    float be[4];
#pragma unroll
    for (int e = 0; e < 4; ++e) be[e] = -slope2 * (float)(i - 4 * G - e);
    f32x4_t sc[9];
#pragma unroll
    for (int t = 0; t < 9; ++t) { const int kl = 16 * (w + t) + i; const int sw = (kl >> 1) & 7;
        const bf16x8 k0 = *(const LAS bf16x8*)(Ks + kl * 128 + 16 * (G ^ sw)), k1 = *(const LAS bf16x8*)(Ks + kl * 128 + 16 * ((4 + G) ^ sw));
        const float toff = -slope2 * (float)(128 - 16 * t);
        f32x4_t acc = {be[0] + toff, be[1] + toff, be[2] + toff, be[3] + toff};
        acc = __builtin_amdgcn_mfma_f32_16x16x32_bf16(k0, qf0, acc, 0, 0, 0);
        acc = __builtin_amdgcn_mfma_f32_16x16x32_bf16(k1, qf1, acc, 0, 0, 0);
        sc[t] = acc; }
#pragma unroll
    for (int e = 0; e < 4; ++e) { if (4 * G + e < i) sc[0][e] = -INFINITY; if (4 * G + e > i) sc[8][e] = -INFINITY; }
    if (a.B == 0) {
#pragma unroll
        for (int t = 0; t < 8; ++t) if (w + t < 8) sc[t] = (f32x4_t){-INFINITY, -INFINITY, -INFINITY, -INFINITY};
    }
    float mx = -INFINITY;
#pragma unroll
    for (int t = 0; t < 9; ++t) mx = fmaxf(fmaxf(mx, fmaxf(sc[t][0], sc[t][1])), fmaxf(sc[t][2], sc[t][3]));
    mx = fmaxf(mx, __shfl_xor(mx, 16)); mx = fmaxf(mx, __shfl_xor(mx, 32));
    float lsum = 0.f;
#pragma unroll
    for (int t = 0; t < 9; ++t)
#pragma unroll
        for (int e = 0; e < 4; ++e) { const float p = __builtin_amdgcn_exp2f(sc[t][e] - mx); sc[t][e] = p; lsum += p; }
    lsum += __shfl_xor(lsum, 16); lsum += __shfl_xor(lsum, 32);
    f32x4_t o[4];
#pragma unroll
    for (int dt = 0; dt < 4; ++dt) o[dt] = (f32x4_t){0.f, 0.f, 0.f, 0.f};
    const int q4 = (lane & 15) >> 2, p4 = lane & 3;
#pragma unroll
    for (int pp = 0; pp < 5; ++pp) { const int t0 = 2 * pp, t1 = (pp < 4) ? 2 * pp + 1 : 8;
        u32x4 pb; pb.x = pkbf(sc[t0][0], sc[t0][1]); pb.y = pkbf(sc[t0][2], sc[t0][3]);
        if (pp < 4) { pb.z = pkbf(sc[t1][0], sc[t1][1]); pb.w = pkbf(sc[t1][2], sc[t1][3]); } else { pb.z = 0u; pb.w = 0u; }
        const int r0 = 16 * (w + t0) + 4 * G + q4, r1 = 16 * (w + t1) + 4 * G + q4;
        const int s0 = ((r0 >> 1) & 3) << 1, s1 = ((r1 >> 1) & 3) << 1;
#pragma unroll
        for (int dt = 0; dt < 4; ++dt) { const int c = 2 * dt + (p4 >> 1);
            const s16x4 lo = tr16(Vs + r0 * 128 + 16 * (c ^ s0) + 8 * (p4 & 1)), hi = tr16(Vs + r1 * 128 + 16 * (c ^ s1) + 8 * (p4 & 1));
            const bf16x8 vf = {lo[0], lo[1], lo[2], lo[3], hi[0], hi[1], hi[2], hi[3]};
            o[dt] = __builtin_amdgcn_mfma_f32_16x16x32_bf16(vf, __builtin_bit_cast(bf16x8, pb), o[dt], 0, 0, 0); } }
    const float inv = __builtin_amdgcn_rcpf(lsum);
#pragma unroll
    for (int dt = 0; dt < 4; ++dt) { u32x2 ov; ov.x = pkbf(o[dt][0] * inv, o[dt][1] * inv); ov.y = pkbf(o[dt][2] * inv, o[dt][3] * inv);
        *(u32x2*)(OG + qrow * 512 + a.h * 64 + 16 * dt + 4 * G) = ov; }
    if (G == 0) LSE[qrow * 8 + a.h] = mx + __builtin_amdgcn_logf(lsum);
}
__device__ __forceinline__ void attn_phase(Ctx& C, int n_items, int first, int stride) {
    int it = first; if (it >= n_items) return;
    AttnPre P; AttnItem cur = attn_decode(it);
    attn_prefetch(C, cur, P);
    int par = 0;
    for (;;) {
        LAS unsigned char* buf = C.lds + par * 65536;
        attn_stage(buf, P, C.tid);
        const bf16x8 qf0 = P.q0, qf1 = P.q1;
        __syncthreads();
        const int nit = it + stride; AttnItem nxt = cur;
        if (nit < n_items) { nxt = attn_decode(nit); attn_prefetch(C, nxt, P); }
        attn_compute(C, cur, buf, qf0, qf1);
        if (nit >= n_items) break;
        it = nit; cur = nxt; par ^= 1;
    }
    __syncthreads();
}

__device__ __forceinline__ void smp_delta_item(Ctx& C, int item) {
    const int b = item >> 2, hd = item & 3, tid = C.tid;
    const float* SPROJ = WSP(float, WS_SPROJ) + (size_t)b * NIN; const float* SG = WSP(float, WS_SGATE) + b * 8;
    LAS float* L = (LAS float*)C.lds;
    LAS float* yq = L; LAS float* yk = L + 128; LAS float* yv = L + 256; LAS float* red = L + 384; LAS float* pk = L + 512; LAS float* pq = L + 1024; LAS float* ob = L + 1536;
    if (tid < 384) { const int which = tid >> 7, c = tid & 127; const int ch = which * 512 + hd * 128 + c;
        const float s0 = C.st_conv[((size_t)b * 3 + 0) * CONV_CH + ch], s1 = C.st_conv[((size_t)b * 3 + 1) * CONV_CH + ch], s2 = C.st_conv[((size_t)b * 3 + 2) * CONV_CH + ch], xn = SPROJ[ch];
        const float y = s0 * C.conv_w[ch] + s1 * C.conv_w[CONV_CH + ch] + s2 * C.conv_w[2 * CONV_CH + ch] + xn * C.conv_w[3 * CONV_CH + ch];
        L[tid] = siluf(y);
        float* sc = C.out + O_SCONV + (size_t)b * 3 * CONV_CH; sc[ch] = s1; sc[CONV_CH + ch] = s2; sc[2 * CONV_CH + ch] = xn; }
    __syncthreads();
    if (tid < 192) { const int wv = tid >> 6, lane = tid & 63;
        const float a0 = (wv == 1 ? yk : yq)[lane], a1 = (wv == 1 ? yk : yq)[lane + 64], b0 = (wv == 0 ? yq : yk)[lane], b1 = (wv == 0 ? yq : yk)[lane + 64];
        const float s = wave_sum(a0 * b0 + a1 * b1); if (lane == 0) red[wv] = s; }
    __syncthreads();
    const float rq = rsqrtf(red[0] + EPS) * 0.08838834764831845f, rk = rsqrtf(red[1] + EPS);
    const float qk = red[2] * rq * rk;
    const float beta = SG[hd], gdec = __expf(SG[4 + hd]);
    const int v = tid & 127, kq = tid >> 7;
    const float* S0 = C.st_ssm + ((size_t)(b * 4 + hd) * DK + 32 * kq) * DV + v;
    float sreg[32]; float aks = 0.f, aqs = 0.f;
#pragma unroll
    for (int k = 0; k < 32; ++k) { sreg[k] = S0[(size_t)k * DV]; aks += yk[32 * kq + k] * sreg[k]; aqs += yq[32 * kq + k] * sreg[k]; }
    pk[kq * 128 + v] = aks; pq[kq * 128 + v] = aqs;
    __syncthreads();
    const float kS = ((pk[v] + pk[128 + v]) + (pk[256 + v] + pk[384 + v])) * rk, qS = ((pq[v] + pq[128 + v]) + (pq[256 + v] + pq[384 + v])) * rq;
    const float vnew = beta * (yv[v] - gdec * kS);
    const float o = gdec * qS + qk * vnew;
    float* S1 = C.out + O_SSSM + ((size_t)(b * 4 + hd) * DK + 32 * kq) * DV + v;
#pragma unroll
    for (int k = 0; k < 32; ++k) S1[(size_t)k * DV] = gdec * sreg[k] + (yk[32 * kq + k] * rk) * vnew;
    if (kq == 0) ob[v] = o;
    __syncthreads();
    if (tid < 64) { const float s = wave_sum(ob[tid] * ob[tid] + ob[tid + 64] * ob[tid + 64]); if (tid == 0) red[4] = s; }
    __syncthreads();
    if (tid < 128) { const float rs = rsqrtf(red[4] * (1.f / DV) + EPS); const float z = SPROJ[CONV_CH + hd * 128 + tid];
        const float r = ob[tid] * rs * C.dn_norm[tid] * siluf(z);
        WSP(bf16_t, WS_SMIX)[(size_t)b * D + hd * 128 + tid] = (bf16_t)(pkbf(r, 0.f) & 0xffffu); }
    __syncthreads();
}

__device__ __forceinline__ void smp_attn_task(Ctx& C, int task) {
    const int half = task & 1, g = (task >> 1) % 3, bh = task / 6, b = bh >> 3, h = bh & 7, lane = C.lane, sub = lane & 15, grp = lane >> 4;
    const int dil = g == 0 ? 1 : (g == 1 ? 4 : 16), r0 = 1 + 64 * half + grp;
    const f32x4 qq = ((const f32x4*)(WSP(float, WS_SPROJ) + (size_t)b * NIN + 2048 + h * 64))[sub];
    const size_t rowb = ((size_t)b * WIN * ATH + h) * ATD;
    f32x4 kv[16], vv[16];
#pragma unroll
    for (int i = 0; i < 16; ++i) kv[i] = ((const f32x4*)(C.ck + rowb + (size_t)(WIN - (r0 + 4 * i) * dil) * (ATH * ATD)))[sub];
#pragma unroll
    for (int i = 0; i < 16; ++i) vv[i] = ((const f32x4*)(C.cv + rowb + (size_t)(WIN - (r0 + 4 * i) * dil) * (ATH * ATD)))[sub];
    const float slope = exp2f(-(float)(h + 1)) * LOG2E;
    float sc[16], m = -3.0e38f;
#pragma unroll
    for (int i = 0; i < 16; ++i) { float d = (qq.x * kv[i].x + qq.y * kv[i].y) + (qq.z * kv[i].z + qq.w * kv[i].w);
        d += __shfl_xor(d, 1); d += __shfl_xor(d, 2); d += __shfl_xor(d, 4); d += __shfl_xor(d, 8);
        sc[i] = d * QSCALE - slope * (float)((r0 + 4 * i) * dil); m = fmaxf(m, sc[i]); }
    m = fmaxf(m, __shfl_xor(m, 16)); m = fmaxf(m, __shfl_xor(m, 32));
    float l = 0.f; f32x4 o = {0.f, 0.f, 0.f, 0.f};
#pragma unroll
    for (int i = 0; i < 16; ++i) { const float p = exp2f(sc[i] - m); l += p; o += vv[i] * p; }
    l += __shfl_xor(l, 16); l += __shfl_xor(l, 32);
    o.x += __shfl_xor(o.x, 16); o.y += __shfl_xor(o.y, 16); o.z += __shfl_xor(o.z, 16); o.w += __shfl_xor(o.w, 16);
    o.x += __shfl_xor(o.x, 32); o.y += __shfl_xor(o.y, 32); o.z += __shfl_xor(o.z, 32); o.w += __shfl_xor(o.w, 32);
    float* P = WSP(float, WS_SATT) + (size_t)task * 66;
    if (grp == 0) { P[2 + 4 * sub] = o.x; P[3 + 4 * sub] = o.y; P[4 + 4 * sub] = o.z; P[5 + 4 * sub] = o.w; }
    if (lane == 0) { P[0] = m; P[1] = l; }
}
__device__ __forceinline__ void smp_attn_merge(Ctx& C, int bh) {
    const int b = bh >> 3, h = bh & 7, lane = C.lane;
    const float* SPROJ = WSP(float, WS_SPROJ) + (size_t)b * NIN;
    const float s0 = wave_sum(SPROJ[2048 + h * 64 + lane] * SPROJ[2560 + h * 64 + lane]) * QSCALE;
    const float* P = WSP(float, WS_SATT) + (size_t)bh * 6 * 66;
    float mx = s0;
#pragma unroll
    for (int t = 0; t < 6; ++t) mx = fmaxf(mx, P[t * 66]);
    const float w0 = 3.f * exp2f(s0 - mx);
    float l = w0, o = w0 * SPROJ[3072 + h * 64 + lane];
#pragma unroll
    for (int t = 0; t < 6; ++t) { const float w = exp2f(P[t * 66] - mx); l += w * P[t * 66 + 1]; o += w * P[t * 66 + 2 + lane]; }
    WSP(bf16_t, WS_SMIX)[(size_t)b * D + 512 + h * 64 + lane] = (bf16_t)(pkbf(o / l, 0.f) & 0xffffu);
}

__device__ __forceinline__ void smp_window_copy(Ctx& C, int part, int nparts) {
    const float* SPROJ = WSP(float, WS_SPROJ);
    const size_t total = (size_t)2 * SB * WIN * 128;
    for (size_t blk = (size_t)part * (8 * NTHREADS); blk < total; blk += (size_t)nparts * (8 * NTHREADS)) {
        f32x4 val[8];
#pragma unroll
        for (int u = 0; u < 8; ++u) { const size_t idx = blk + u * NTHREADS + C.tid;
            const int c4 = (int)(idx & 127); const size_t rowi = idx >> 7; const int jrow = (int)(rowi & (WIN - 1)); const int b = (int)((rowi >> 11) & 31); const int kv = (int)(rowi >> 16);
            if (jrow < WIN - 1) val[u] = __builtin_nontemporal_load((const f32x4*)(kv ? C.cv : C.ck) + ((size_t)b * WIN + jrow + 1) * 128 + c4);
            else val[u] = *(const f32x4*)(SPROJ + (size_t)b * NIN + (kv ? 3072 : 2560) + 4 * c4); }
#pragma unroll
        for (int u = 0; u < 8; ++u) { const size_t idx = blk + u * NTHREADS + C.tid;
            const int c4 = (int)(idx & 127); const size_t rowi = idx >> 7; const int jrow = (int)(rowi & (WIN - 1)); const int b = (int)((rowi >> 11) & 31); const int kv = (int)(rowi >> 16);
            __builtin_nontemporal_store(val[u], (f32x4*)(C.out + (kv ? O_SWV : O_SWK)) + ((size_t)b * WIN + jrow) * 128 + c4); }
    }
}

constexpr int PL_KN = 0, PL_VV = 33792, PL_QB = 67584, PL_MM = 84992, PL_WB = 102400, PL_SM = 119808, PL_TD = 121856;
__device__ __forceinline__ LAS unsigned char* opaque_lds(LAS unsigned char* p) { unsigned v = (unsigned)(uintptr_t)p; asm volatile("" : "+v"(v)); return (LAS unsigned char*)(uintptr_t)v; }
__device__ __forceinline__ bf16x8 ld_f32x8_as_bf16(const LAS float* p) { const f32x4 a = *(const LAS f32x4*)p, b = *(const LAS f32x4*)(p + 4);
    u32x4 o; o.x = pkbf(a.x, a.y); o.y = pkbf(a.z, a.w); o.z = pkbf(b.x, b.y); o.w = pkbf(b.z, b.w); return __builtin_bit_cast(bf16x8, o); }

struct PrepPre { u32x4 r[11]; float be, g; };
__device__ __forceinline__ void prep_prefetch(Ctx& C, int item, PrepPre& P) {
    const int c = item & 63, hd = (item >> 6) & 3, n = item >> 8, tid = C.tid; const size_t seq0 = (size_t)n * SEQ;
    if (tid < 384) { const int cg = tid % 48, seg = tid / 48, which = cg >> 4, c8 = cg & 15; const int chb = which * 512 + hd * 128 + 8 * c8;
        const bf16_t* PRE = WSP(bf16_t, WS_PRE);
#pragma unroll
        for (int rr = 0; rr < 11; ++rr) { const int t = 64 * c + 8 * seg + rr - 3; u32x4 v = {0u, 0u, 0u, 0u};
            if (t >= 0) v = *(const u32x4*)(PRE + (seq0 + t) * CONV_CH + chb);
            P.r[rr] = v; }
    } else if (C.wave == 6) { const size_t row = seq0 + 64 * c + C.lane; P.be = WSP(float, WS_BETA)[row * 4 + hd]; P.g = WSP(float, WS_GG)[row * 4 + hd]; }
}
__device__ __forceinline__ void gdn_prep_item(Ctx& C, int item, PrepPre& P, int next_item) {
    const int c = item & 63, hd = (item >> 6) & 3, n = item >> 8;
    const int tid = C.tid, lane = C.lane, wave = C.wave;
    const size_t seq0 = (size_t)n * SEQ;
    LAS unsigned char* L0 = opaque_lds(C.lds);
    LAS float* KN = (LAS float*)(L0 + PL_KN); LAS float* VV = (LAS float*)(L0 + PL_VV); LAS bf16_t* QB = (LAS bf16_t*)(L0 + PL_QB);
    LAS float* MM = (LAS float*)(L0 + PL_MM); LAS bf16_t* WB = (LAS bf16_t*)(L0 + PL_WB); LAS float* SM = (LAS float*)(L0 + PL_SM);
    LAS float* s_beta = SM; LAS float* s_gc = SM + 64; LAS float* s_egc = SM + 128; LAS float* s_ekd = SM + 192; LAS float* s_bw = SM + 256; LAS float* TD = (LAS float*)(L0 + PL_TD);
    unsigned char* img = C.ws + WS_GDN + (size_t)item * GDN_CHUNK_BYTES;
    if (tid < 384) {
        const int cg = tid % 48, seg = tid / 48, which = cg >> 4, c8 = cg & 15; const int chb = which * 512 + hd * 128 + 8 * c8;
        float cw[4][8];
#pragma unroll
        for (int i = 0; i < 4; ++i) { const f32x4 a = *(const f32x4*)(C.conv_w + i * CONV_CH + chb), b = *(const f32x4*)(C.conv_w + i * CONV_CH + chb + 4);
            cw[i][0] = a.x; cw[i][1] = a.y; cw[i][2] = a.z; cw[i][3] = a.w; cw[i][4] = b.x; cw[i][5] = b.y; cw[i][6] = b.z; cw[i][7] = b.w; }
        float xr[11][8];
#pragma unroll
        for (int rr = 0; rr < 11; ++rr) { const u32x4 v = P.r[rr];
            xr[rr][0] = bflo(v.x); xr[rr][1] = bfhi(v.x); xr[rr][2] = bflo(v.y); xr[rr][3] = bfhi(v.y); xr[rr][4] = bflo(v.z); xr[rr][5] = bfhi(v.z); xr[rr][6] = bflo(v.w); xr[rr][7] = bfhi(v.w); }
#pragma unroll
        for (int tt = 0; tt < 8; ++tt) { float y[8]; float ss = 0.f;
#pragma unroll
            for (int e = 0; e < 8; ++e) { const float a = (xr[tt][e] * cw[0][e] + xr[tt + 1][e] * cw[1][e]) + (xr[tt + 2][e] * cw[2][e] + xr[tt + 3][e] * cw[3][e]); y[e] = siluf(a); ss += y[e] * y[e]; }
            ss += __shfl_xor(ss, 1); ss += __shfl_xor(ss, 2); ss += __shfl_xor(ss, 4); ss += __shfl_xor(ss, 8);
            const int row = 8 * seg + tt;
            if (which == 0) { const float sc = rsqrtf(ss + EPS) * 0.08838834764831845f;
                u32x4 o; o.x = pkbf(y[0] * sc, y[1] * sc); o.y = pkbf(y[2] * sc, y[3] * sc); o.z = pkbf(y[4] * sc, y[5] * sc); o.w = pkbf(y[6] * sc, y[7] * sc);
                *(LAS u32x4*)(QB + row * 136 + 8 * c8) = o; }
            else { const float sc = which == 1 ? rsqrtf(ss + EPS) : 1.f; LAS float* dst = (which == 1 ? KN : VV) + row * 132 + 8 * c8;
                *(LAS f32x4*)dst = (f32x4){y[0] * sc, y[1] * sc, y[2] * sc, y[3] * sc}; *(LAS f32x4*)(dst + 4) = (f32x4){y[4] * sc, y[5] * sc, y[6] * sc, y[7] * sc}; } }
    } else if (wave == 6) {
        const float be = P.be; float x = P.g;
#pragma unroll
        for (int off = 1; off < 64; off <<= 1) { const float t = __shfl_up(x, off); if (lane >= off) x += t; }
        const float gl = __shfl(x, 63);
        s_beta[lane] = be; s_gc[lane] = x; s_egc[lane] = __expf(x); s_ekd[lane] = __expf(gl - x); s_bw[lane] = be * __expf(x);
        if (lane == 0) WSP(float, WS_EGL)[item] = __expf(gl);
    }
    __syncthreads();
    if (next_item >= 0) prep_prefetch(C, next_item, P);
    if (wave < 6) {
        const int kind = wave / 3, tsel = wave % 3; const int it = tsel == 1 ? 0 : 1, jt = tsel == 2 ? 1 : 0;
        const int r = lane & 31, hh = lane >> 5;
        f32x16 acc;
#pragma unroll
        for (int e = 0; e < 16; ++e) acc[e] = 0.f;
#pragma unroll
        for (int ks = 0; ks < 8; ++ks) { const bf16x8 a = ld_f32x8_as_bf16(KN + (32 * jt + r) * 132 + 16 * ks + 8 * hh);
            bf16x8 b; if (kind == 0) b = ld_f32x8_as_bf16(KN + (32 * it + r) * 132 + 16 * ks + 8 * hh); else b = *(const LAS bf16x8*)(QB + (32 * it + r) * 136 + 16 * ks + 8 * hh);
            acc = __builtin_amdgcn_mfma_f32_32x32x16_bf16(a, b, acc, 0, 0, 0); }
        const int i = 32 * it + r; const float gci = s_gc[i], nbi = -s_beta[i];
        float vals[16];
#pragma unroll
        for (int e = 0; e < 16; ++e) { const int j = 32 * jt + (e & 3) + 8 * (e >> 2) + 4 * hh; const float dec = __expf(gci - s_gc[j]);
            vals[e] = kind == 0 ? ((i > j) ? nbi * acc[e] * dec : 0.f) : ((i >= j) ? acc[e] * dec : 0.f); }
        if (kind == 0) {
#pragma unroll
            for (int a4 = 0; a4 < 4; ++a4) *(LAS f32x4*)(MM + i * 68 + 32 * jt + 8 * a4 + 4 * hh) = (f32x4){vals[4 * a4], vals[4 * a4 + 1], vals[4 * a4 + 2], vals[4 * a4 + 3]};
        } else {
#pragma unroll
            for (int s = 0; s < 2; ++s) { u32x4 o; o.x = pkbf(vals[8 * s], vals[8 * s + 1]); o.y = pkbf(vals[8 * s + 2], vals[8 * s + 3]); o.z = pkbf(vals[8 * s + 4], vals[8 * s + 5]); o.w = pkbf(vals[8 * s + 6], vals[8 * s + 7]);
                *(u32x4*)(img + GI_QK + ((it * 4 + 2 * jt + s) * 64 + lane) * 16) = o; }
        }
    } else {
        const int t2 = tid - 384;
#pragma unroll
        for (int q = 0; q < 8; ++q) { const int f = t2 + 128 * q; const int lf = f & 63, kk = (f >> 6) & 7, rt = f >> 9; const int r = lf & 31, hh = lf >> 5;
            const int i = 32 * rt + r, cb = 32 * (kk >> 1) + 16 * (kk & 1) + 4 * hh; const float e = s_egc[i];
            const u32x2 a = *(const LAS u32x2*)(QB + i * 136 + cb), b = *(const LAS u32x2*)(QB + i * 136 + cb + 8);
            u32x4 o; o.x = pkbf(bflo(a.x) * e, bfhi(a.x) * e); o.y = pkbf(bflo(a.y) * e, bfhi(a.y) * e); o.z = pkbf(bflo(b.x) * e, bfhi(b.x) * e); o.w = pkbf(bflo(b.y) * e, bfhi(b.y) * e);
            *(u32x4*)(img + GI_QG + f * 16) = o; }
    }
    __syncthreads();
    if (wave == 0) {
        const int d = lane >> 4, j = lane & 15; const LAS float* Md = MM + (16 * d) * 68 + 16 * d; float t[16];
#pragma unroll
        for (int i = 0; i < 16; ++i) { float a = (i == j) ? 1.f : 0.f;
#pragma unroll
            for (int k = 0; k < i; ++k) a += Md[i * 68 + k] * t[k];
            t[i] = a; TD[(d * 16 + i) * 16 + j] = a; }
    } else if (wave >= 4) {
        const int t2 = tid - 256;
#pragma unroll
        for (int q = 0; q < 4; ++q) { const int f = t2 + 256 * q; const int lf = f & 63, kk = (f >> 6) & 3, rt = f >> 8; const int r = lf & 31, hh = lf >> 5;
            const int cc = 32 * rt + r, tb = 32 * (kk >> 1) + 16 * (kk & 1) + 4 * hh; float v[8];
#pragma unroll
            for (int jj = 0; jj < 8; ++jj) { const int tk = tb + 8 * (jj >> 2) + (jj & 3); v[jj] = KN[tk * 132 + cc] * s_ekd[tk]; }
            u32x4 o; o.x = pkbf(v[0], v[1]); o.y = pkbf(v[2], v[3]); o.z = pkbf(v[4], v[5]); o.w = pkbf(v[6], v[7]);
            *(u32x4*)(img + GI_KD + f * 16) = o; }
    }
    __syncthreads();
    {
        const int i16 = lane & 15, G = lane >> 4; const bool isw = wave >= 4;
        const LAS float* src = (isw ? KN : VV) + 32 * (wave & 3) + i16; const LAS float* scl = isw ? s_bw : s_beta;
        f32x4 X[4][2];
#pragma unroll
        for (int bi = 0; bi < 4; ++bi) {
#pragma unroll
            for (int tl = 0; tl < 2; ++tl)
#pragma unroll
                for (int e = 0; e < 4; ++e) { const int row = 16 * bi + 4 * G + e; X[bi][tl][e] = scl[row] * src[row * 132 + 16 * tl]; }
#pragma unroll
            for (int bj = 0; bj < bi; ++bj) { const f32x4 a = *(const LAS f32x4*)(MM + (16 * bi + i16) * 68 + 16 * bj + 4 * G);
#pragma unroll
                for (int s4 = 0; s4 < 4; ++s4)
#pragma unroll
                    for (int tl = 0; tl < 2; ++tl) X[bi][tl] = __builtin_amdgcn_mfma_f32_16x16x4f32(a[s4], X[bj][tl][s4], X[bi][tl], 0, 0, 0); }
            const f32x4 td = *(const LAS f32x4*)(TD + (bi * 16 + i16) * 16 + 4 * G);
            f32x4 y0 = {0.f, 0.f, 0.f, 0.f}, y1 = {0.f, 0.f, 0.f, 0.f};
#pragma unroll
            for (int s4 = 0; s4 < 4; ++s4) { y0 = __builtin_amdgcn_mfma_f32_16x16x4f32(td[s4], X[bi][0][s4], y0, 0, 0, 0); y1 = __builtin_amdgcn_mfma_f32_16x16x4f32(td[s4], X[bi][1][s4], y1, 0, 0, 0); }
            X[bi][0] = y0; X[bi][1] = y1;
        }
        if (!isw) {
#pragma unroll
            for (int bi = 0; bi < 4; ++bi)
#pragma unroll
                for (int tl = 0; tl < 2; ++tl) { u32x2 o; o.x = pkbf(X[bi][tl][0], X[bi][tl][1]); o.y = pkbf(X[bi][tl][2], X[bi][tl][3]);
                    *(u32x2*)(img + GI_U + (((wave * 2 + (bi >> 1)) * 64) + 32 * (G & 1) + 16 * tl + i16) * 32 + 8 * (2 * (bi & 1) + (G >> 1))) = o; }
        } else {
#pragma unroll
            for (int bi = 0; bi < 4; ++bi)
#pragma unroll
                for (int tl = 0; tl < 2; ++tl)
#pragma unroll
                    for (int e = 0; e < 4; ++e) WB[(16 * bi + 4 * G + e) * 136 + 32 * (wave - 4) + 16 * tl + i16] = (bf16_t)(pkbf(-X[bi][tl][e], 0.f) & 0xffffu);
        }
    }
    __syncthreads();
#pragma unroll
    for (int q = 0; q < 2; ++q) { const int f = tid + 512 * q; const int lf = f & 63, kk = (f >> 6) & 7, rt = f >> 9; const int r = lf & 31, hh = lf >> 5;
        const int i = 32 * rt + r, cb = 32 * (kk >> 1) + 16 * (kk & 1) + 4 * hh;
        const u32x2 a = *(const LAS u32x2*)(WB + i * 136 + cb), b = *(const LAS u32x2*)(WB + i * 136 + cb + 8);
        *(u32x4*)(img + GI_NW + f * 16) = (u32x4){a.x, a.y, b.x, b.y}; }
}

constexpr int SC_BUF = 57344;
__device__ __forceinline__ bf16x8 pack8(const f32x16& a, int s) {
    u32x4 o; o.x = pkbf(a[8 * s + 0], a[8 * s + 1]); o.y = pkbf(a[8 * s + 2], a[8 * s + 3]); o.z = pkbf(a[8 * s + 4], a[8 * s + 5]); o.w = pkbf(a[8 * s + 6], a[8 * s + 7]); return __builtin_bit_cast(bf16x8, o); }
constexpr int SC_SLOTA = 32768, SC_SLOTB = 38912, SC_B0 = 2 * SC_SLOTA, SC_STG = SC_B0 + 2 * SC_SLOTB, SC_END = SC_STG + 16384;
__device__ __forceinline__ void gdn_scan_item(Ctx& C, int item) {
    const int n = item >> 2, hd = item & 3, lane = C.lane, wave = C.wave, w4 = wave - 4;
    const unsigned char* base = C.ws + WS_GDN + (size_t)item * 64 * GDN_CHUNK_BYTES;
    const float* EGL = WSP(float, WS_EGL) + item * 64;
    bf16_t* ORAW = WSP(bf16_t, WS_ORAW);
    LAS unsigned char* L0 = opaque_lds(C.lds);
#define SC_BAR() do { asm volatile("s_waitcnt lgkmcnt(0)" ::: "memory"); __builtin_amdgcn_s_barrier(); asm volatile("" ::: "memory"); } while (0)
#define SC_PIN() __builtin_amdgcn_sched_barrier(0)
    if (wave < 4) {
      f32x16 S[4];
#pragma unroll
      for (int a = 0; a < 4; ++a) {
#pragma unroll
        for (int e = 0; e < 16; ++e) S[a][e] = 0.f; }
      const unsigned eglv = __float_as_uint(EGL[lane]);
      SC_BAR();
      for (int c = 0; c < NCH; ++c) {
        int ln = lane; asm volatile("" : "+v"(ln));
        const int lr = ln & 31, lh = ln >> 5;
        const LAS unsigned char* sa = L0 + (c & 1) * SC_SLOTA; const LAS unsigned char* sbp = L0 + SC_B0 + (c & 1) * SC_SLOTB;
        const LAS unsigned char* fNW = sa + ln * 16; const LAS unsigned char* fU = sa + 16384 + ((wave * 2) * 64 + ln) * 32;
        const LAS unsigned char* fQG = sbp + ln * 16; const LAS unsigned char* fQK = sbp + 16384 + ln * 16; const LAS unsigned char* fKD = sbp + 22528 + ln * 16;
        bf16x8 G0[8], G1[8];
#define SC_RD(G, ptr, i0) do { _Pragma("unroll") for (int i_ = 0; i_ < 8; ++i_) G[i_] = *(const LAS bf16x8*)((ptr) + ((i0) + i_) * 1024); } while (0)
#define SC_RD_H(G, ptr, h) do { _Pragma("unroll") for (int i_ = 0; i_ < 4; ++i_) { G[i_] = *(const LAS bf16x8*)((ptr) + (4 * (h) + i_) * 1024); G[4 + i_] = *(const LAS bf16x8*)((ptr) + (8 + 4 * (h) + i_) * 1024); } } while (0)
        u32x4 uu[2][2];
#pragma unroll
        for (int rt = 0; rt < 2; ++rt) { uu[rt][0] = *(const LAS u32x4*)(fU + rt * 2048); uu[rt][1] = *(const LAS u32x4*)(fU + rt * 2048 + 16); }
        SC_RD_H(G0, fNW, 0); SC_RD_H(G1, fNW, 1); SC_PIN();
        f32x16 Y[2];
#pragma unroll
        for (int rt = 0; rt < 2; ++rt)
#pragma unroll
            for (int q = 0; q < 2; ++q) { const u32x4 u = uu[rt][q];
                Y[rt][8 * q + 0] = bflo(u.x); Y[rt][8 * q + 1] = bfhi(u.x); Y[rt][8 * q + 2] = bflo(u.y); Y[rt][8 * q + 3] = bfhi(u.y);
                Y[rt][8 * q + 4] = bflo(u.z); Y[rt][8 * q + 5] = bfhi(u.z); Y[rt][8 * q + 6] = bflo(u.w); Y[rt][8 * q + 7] = bfhi(u.w); }
#pragma unroll
        for (int k4 = 0; k4 < 4; ++k4) { const bf16x8 sb = pack8(S[k4 >> 1], k4 & 1);
            Y[0] = __builtin_amdgcn_mfma_f32_32x32x16_bf16(G0[k4], sb, Y[0], 0, 0, 0); Y[1] = __builtin_amdgcn_mfma_f32_32x32x16_bf16(G0[4 + k4], sb, Y[1], 0, 0, 0); }
        SC_PIN(); SC_RD_H(G0, fQG, 0); SC_PIN();
#pragma unroll
        for (int k4 = 0; k4 < 4; ++k4) { const bf16x8 sb = pack8(S[2 + (k4 >> 1)], k4 & 1);
            Y[0] = __builtin_amdgcn_mfma_f32_32x32x16_bf16(G1[k4], sb, Y[0], 0, 0, 0); Y[1] = __builtin_amdgcn_mfma_f32_32x32x16_bf16(G1[4 + k4], sb, Y[1], 0, 0, 0); }
        SC_PIN(); SC_RD_H(G1, fQG, 1); SC_PIN();
        f32x16 O[2];
#pragma unroll
        for (int rt = 0; rt < 2; ++rt)
#pragma unroll
            for (int e = 0; e < 16; ++e) O[rt][e] = 0.f;
#pragma unroll
        for (int k4 = 0; k4 < 4; ++k4) { const bf16x8 sb = pack8(S[k4 >> 1], k4 & 1);
            O[0] = __builtin_amdgcn_mfma_f32_32x32x16_bf16(G0[k4], sb, O[0], 0, 0, 0); O[1] = __builtin_amdgcn_mfma_f32_32x32x16_bf16(G0[4 + k4], sb, O[1], 0, 0, 0); }
        SC_PIN();
#pragma unroll
        for (int i = 0; i < 6; ++i) G0[i] = *(const LAS bf16x8*)(fQK + i * 1024);
        SC_PIN();
#pragma unroll
        for (int k4 = 0; k4 < 4; ++k4) { const bf16x8 sb = pack8(S[2 + (k4 >> 1)], k4 & 1);
            O[0] = __builtin_amdgcn_mfma_f32_32x32x16_bf16(G1[k4], sb, O[0], 0, 0, 0); O[1] = __builtin_amdgcn_mfma_f32_32x32x16_bf16(G1[4 + k4], sb, O[1], 0, 0, 0); }
        SC_PIN(); SC_RD(G1, fKD, 0); SC_PIN();
        bf16x8 Yb[2][2];
#pragma unroll
        for (int yt = 0; yt < 2; ++yt) { Yb[yt][0] = pack8(Y[yt], 0); Yb[yt][1] = pack8(Y[yt], 1); }
        O[0] = __builtin_amdgcn_mfma_f32_32x32x16_bf16(G0[0], Yb[0][0], O[0], 0, 0, 0); O[0] = __builtin_amdgcn_mfma_f32_32x32x16_bf16(G0[1], Yb[0][1], O[0], 0, 0, 0);
#pragma unroll
        for (int kk = 0; kk < 4; ++kk) O[1] = __builtin_amdgcn_mfma_f32_32x32x16_bf16(G0[2 + kk], Yb[kk >> 1][kk & 1], O[1], 0, 0, 0);
        SC_PIN(); SC_RD(G0, fKD, 8); SC_PIN();
        const float egl = __uint_as_float(__builtin_amdgcn_readlane(eglv, c));
#pragma unroll
        for (int a = 0; a < 2; ++a) {
#pragma unroll
            for (int e = 0; e < 16; ++e) S[a][e] *= egl;
#pragma unroll
            for (int kk = 0; kk < 4; ++kk) S[a] = __builtin_amdgcn_mfma_f32_32x32x16_bf16(G1[a * 4 + kk], Yb[kk >> 1][kk & 1], S[a], 0, 0, 0); }
        { LAS bf16_t* stg = (LAS bf16_t*)(L0 + SC_STG) + (4 * lh) * 128 + wave * 32 + lr;
#pragma unroll
          for (int rt = 0; rt < 2; ++rt)
#pragma unroll
            for (int e = 0; e < 16; ++e) stg[(32 * rt + (e & 3) + 8 * (e >> 2)) * 128] = (bf16_t)(pkbf(O[rt][e], 0.f) & 0xffffu); }
        SC_BAR();
#pragma unroll
        for (int a = 2; a < 4; ++a) {
#pragma unroll
            for (int e = 0; e < 16; ++e) S[a][e] *= egl;
#pragma unroll
            for (int kk = 0; kk < 4; ++kk) S[a] = __builtin_amdgcn_mfma_f32_32x32x16_bf16(G0[(a - 2) * 4 + kk], Yb[kk >> 1][kk & 1], S[a], 0, 0, 0); }
        SC_BAR();
#undef SC_RD
#undef SC_RD_H
      }
      { const int r = lane & 31, hh = lane >> 5;
        float* ps = C.out + O_PSSM + ((size_t)item * DK + 4 * hh) * DV + wave * 32 + r;
#pragma unroll
        for (int a = 0; a < 4; ++a)
#pragma unroll
            for (int e = 0; e < 16; ++e) ps[(size_t)(32 * a + (e & 3) + 8 * (e >> 2)) * DV] = S[a][e]; }
    } else {
      u32x4 RA0[8], RB0[10], RA1[8], RB1[10];
#define SC_LD_A(RA, cidx, LN) do { const int cc_ = (cidx) < NCH ? (cidx) : NCH - 1; const unsigned char* g_ = base + (size_t)cc_ * GDN_CHUNK_BYTES + (LN) * 16 + w4 * 1024; \
        _Pragma("unroll") for (int q_ = 0; q_ < 4; ++q_) RA[q_] = *(const u32x4*)(g_ + GI_NW + q_ * 4096); \
        _Pragma("unroll") for (int q_ = 0; q_ < 4; ++q_) RA[4 + q_] = *(const u32x4*)(g_ + GI_U + q_ * 4096); } while (0)
#define SC_LD_B(RB, cidx, LN) do { const int cc_ = (cidx) < NCH ? (cidx) : NCH - 1; const unsigned char* g_ = base + (size_t)cc_ * GDN_CHUNK_BYTES + (LN) * 16 + w4 * 1024; \
        _Pragma("unroll") for (int q_ = 0; q_ < 10; ++q_) RB[q_] = *(const u32x4*)(g_ + GI_QG + q_ * 4096); } while (0)
#define SC_ST_A(RA, slot, LN) do { LAS unsigned char* la_ = L0 + (slot) * SC_SLOTA + w4 * 1024 + (LN) * 16; \
        _Pragma("unroll") for (int q_ = 0; q_ < 4; ++q_) *(LAS u32x4*)(la_ + q_ * 4096) = RA[q_]; \
        _Pragma("unroll") for (int q_ = 0; q_ < 4; ++q_) *(LAS u32x4*)(la_ + 16384 + q_ * 4096) = RA[4 + q_]; } while (0)
#define SC_ST_B(RB, slot, LN) do { LAS unsigned char* lb_ = L0 + SC_B0 + (slot) * SC_SLOTB + w4 * 1024 + (LN) * 16; \
        _Pragma("unroll") for (int q_ = 0; q_ < 10; ++q_) { if (q_ < 4) *(LAS u32x4*)(lb_ + q_ * 4096) = RB[q_]; else if (q_ == 4) { if (w4 < 2) *(LAS u32x4*)(lb_ + q_ * 4096) = RB[q_]; } else *(LAS u32x4*)(lb_ + q_ * 4096 - 2048) = RB[q_]; } } while (0)
#define SC_OUT(cidx, LN) do { const LAS unsigned char* st_ = L0 + SC_STG + w4 * 4096 + (LN) * 16; \
        bf16_t* op_ = ORAW + ((size_t)n * SEQ + 64 * (cidx) + 16 * w4 + ((LN) >> 4)) * 512 + hd * 128 + ((LN) & 15) * 8; \
        _Pragma("unroll") for (int q_ = 0; q_ < 4; ++q_) *(u32x4*)(op_ + (size_t)(4 * q_) * 512) = *(const LAS u32x4*)(st_ + q_ * 1024); } while (0)
      SC_LD_A(RA0, 0, lane); SC_LD_B(RB0, 0, lane); SC_LD_A(RA1, 1, lane); SC_LD_B(RB1, 1, lane);
      SC_ST_A(RA0, 0, lane); SC_ST_B(RB0, 0, lane); SC_ST_A(RA1, 1, lane);
      SC_LD_A(RA0, 2, lane); SC_LD_B(RB0, 2, lane); SC_LD_A(RA1, 3, lane);
      SC_BAR();
      for (int c2 = 0; c2 < NCH; c2 += 2) {
        int ln = lane; asm volatile("" : "+v"(ln));
        SC_BAR(); SC_OUT(c2, ln); SC_ST_B(RB1, 1, ln); SC_LD_B(RB1, c2 + 3, ln);
        SC_BAR(); SC_ST_A(RA0, 0, ln); SC_LD_A(RA0, c2 + 4, ln);
        SC_BAR(); SC_OUT(c2 + 1, ln); SC_ST_B(RB0, 0, ln); SC_LD_B(RB0, c2 + 4, ln);
        SC_BAR(); SC_ST_A(RA1, 1, ln); SC_LD_A(RA1, c2 + 5, ln);
      }
#undef SC_LD_A
#undef SC_LD_B
#undef SC_ST_A
#undef SC_ST_B
#undef SC_OUT
    }
    VM_WAIT();
    __syncthreads();
#undef SC_BAR
#undef SC_PIN
}

__device__ __forceinline__ void p2_mixprep(Ctx& C) {
    constexpr int N_PREP = NB * NHD * NCH, N_SD = SB * NHD, N_SA = SB * ATH * 6 / NWAVES;
    for (int it = C.bid; it < N_SD; it += C.G) smp_delta_item(C, it);
    for (int it = C.G - 1 - C.bid; it < N_SA; it += C.G) { const int b = it / 6, gh = it % 6;
        smp_attn_task(C, ((b * ATH + C.wave) * 3 + (gh >> 1)) * 2 + (gh & 1)); }
    __syncthreads();
    { PrepPre P; if (C.bid < N_PREP) prep_prefetch(C, C.bid, P);
      for (int it = C.bid; it < N_PREP; it += C.G) gdn_prep_item(C, it, P, it + C.G < N_PREP ? it + C.G : -1); }
}
__device__ __forceinline__ void p3_scan(Ctx& C) {
    constexpr int N_SCAN = NB * NHD, N_ATT = NB * ATH * 96;
    if (C.bid < N_SCAN) gdn_scan_item(C, C.bid);
    else { const int part = C.bid - N_SCAN, np = C.G - N_SCAN;
        if ((part >> 3) & 1) { attn_phase(C, N_ATT, part, np); late_weight_copies(C, part, np); smp_window_copy(C, part, np); }
        else { late_weight_copies(C, part, np); smp_window_copy(C, part, np); attn_phase(C, N_ATT, part, np); } }
}

__device__ __forceinline__ void p4_combine(Ctx& C) {
    const int gw = C.bid * NWAVES + C.wave, NGW = C.G * NWAVES, lane = C.lane;
    const bf16_t* ORAW = WSP(bf16_t, WS_ORAW); const bf16_t* Z = WSP(bf16_t, WS_Z);
    const bf16_t* O1 = WSP(bf16_t, WS_O1); const bf16_t* O2 = WSP(bf16_t, WS_O2); const bf16_t* O3 = WSP(bf16_t, WS_O3);
    float nw[8];
#pragma unroll
    for (int e = 0; e < 8; ++e) nw[e] = C.dn_norm[(8 * lane + e) & 127];
    const float* LSE = WSP(float, WS_LSE); bf16_t* MIX = WSP(bf16_t, WS_MIX);
    for (int bh = gw; bh < SB * ATH; bh += NGW) smp_attn_merge(C, bh);
    for (int row = gw; row < M; row += NGW) {
        { const u32x4 ov = *(const u32x4*)(ORAW + (size_t)row * 512 + 8 * lane), zv = *(const u32x4*)(Z + (size_t)row * 512 + 8 * lane);
          float o[8], z[8];
          o[0] = bflo(ov.x); o[1] = bfhi(ov.x); o[2] = bflo(ov.y); o[3] = bfhi(ov.y); o[4] = bflo(ov.z); o[5] = bfhi(ov.z); o[6] = bflo(ov.w); o[7] = bfhi(ov.w);
          z[0] = bflo(zv.x); z[1] = bfhi(zv.x); z[2] = bflo(zv.y); z[3] = bfhi(zv.y); z[4] = bflo(zv.z); z[5] = bfhi(zv.z); z[6] = bflo(zv.w); z[7] = bfhi(zv.w);
          float s = 0.f;
#pragma unroll
          for (int e = 0; e < 8; ++e) s += o[e] * o[e];
          s += __shfl_xor(s, 1); s += __shfl_xor(s, 2); s += __shfl_xor(s, 4); s += __shfl_xor(s, 8);
          const float rs = rsqrtf(s * (1.f / DV) + EPS);
          float r[8];
#pragma unroll
          for (int e = 0; e < 8; ++e) r[e] = o[e] * rs * nw[e] * siluf(z[e]);
          u32x4 w; w.x = pkbf(r[0], r[1]); w.y = pkbf(r[2], r[3]); w.z = pkbf(r[4], r[5]); w.w = pkbf(r[6], r[7]);
          *(u32x4*)(MIX + (size_t)row * D + 8 * lane) = w; }
        const int h = lane >> 3;
        const float l1 = LSE[(size_t)row * 8 + h], l2 = LSE[(size_t)(M + row) * 8 + h], l3 = LSE[(size_t)(2 * M + row) * 8 + h];
        const float mx = fmaxf(l1, fmaxf(l2, l3));
        float w1 = exp2f(l1 - mx), w2 = exp2f(l2 - mx), w3 = exp2f(l3 - mx); const float inv = 1.f / (w1 + w2 + w3); w1 *= inv; w2 *= inv; w3 *= inv;
        const u32x4 a = *(const u32x4*)(O1 + (size_t)row * 512 + 8 * lane), b = *(const u32x4*)(O2 + (size_t)row * 512 + 8 * lane), c = *(const u32x4*)(O3 + (size_t)row * 512 + 8 * lane);
        u32x4 q;
        q.x = pkbf(w1 * bflo(a.x) + w2 * bflo(b.x) + w3 * bflo(c.x), w1 * bfhi(a.x) + w2 * bfhi(b.x) + w3 * bfhi(c.x));
        q.y = pkbf(w1 * bflo(a.y) + w2 * bflo(b.y) + w3 * bflo(c.y), w1 * bfhi(a.y) + w2 * bfhi(b.y) + w3 * bfhi(c.y));
        q.z = pkbf(w1 * bflo(a.z) + w2 * bflo(b.z) + w3 * bflo(c.z), w1 * bfhi(a.z) + w2 * bfhi(b.z) + w3 * bfhi(c.z));
        q.w = pkbf(w1 * bflo(a.w) + w2 * bflo(b.w) + w3 * bflo(c.w), w1 * bfhi(a.w) + w2 * bfhi(b.w) + w3 * bfhi(c.w));
        *(u32x4*)(MIX + (size_t)row * D + 512 + 8 * lane) = q;
    }
}

struct EpiOut {
    static constexpr bool PERM = true, AFTER_DRAIN = false;
    const float* x; float* x1; bf16_t* x1b; float* ssq;
    __device__ __forceinline__ void operator()(const f32x4 (&acc)[2][2][4][2], const pg8::Unit& u, int wr, int wc, int fr, int fq) const {
        const int row0 = u.pm * 256 + wr * 64 + fr, col0 = u.pn * 256 + wc * 32 + 8 * fq;
#pragma unroll
        for (int ai = 0; ai < 2; ++ai)
#pragma unroll
            for (int m = 0; m < 4; ++m) { const int r = row0 + ai * 128 + m * 16; float s = 0.f;
#pragma unroll
                for (int bj = 0; bj < 2; ++bj) { const size_t off = (size_t)r * D + col0 + bj * 128;
                    const f32x4 v0 = *(const f32x4*)(x + off) + acc[ai][bj][m][0], v1 = *(const f32x4*)(x + off + 4) + acc[ai][bj][m][1];
                    u32x4 w; w.x = pkbf(v0[0], v0[1]); w.y = pkbf(v0[2], v0[3]); w.z = pkbf(v1[0], v1[1]); w.w = pkbf(v1[2], v1[3]);
                    *(u32x4*)(x1b + off) = w;
                    s += (v0[0] * v0[0] + v0[1] * v0[1]) + (v0[2] * v0[2] + v0[3] * v0[3]) + (v1[0] * v1[0] + v1[1] * v1[1]) + (v1[2] * v1[2] + v1[3] * v1[3]); }
                s += __shfl_xor(s, 16); s += __shfl_xor(s, 32);
                if (fq == 0) ssq[(size_t)r * 16 + u.pn * 4 + wc] = s; }
    }
};
__device__ __forceinline__ void p5_outproj(Ctx& C) {
    pg8::Gemm g{WSP(bf16_t, WS_MIX), WSP(bf16_t, WS_WOUT), M, D, D}; pg8::StaticOrder S; S.init(M, D, C.G, C.bid);
    EpiOut E{C.x, C.out + O_Y, WSP(bf16_t, WS_X1B), WSP(float, WS_SSQ1)};
    pg8::gemm_phase<EpiOut, pg8::StaticOrder, true, true>(C.lds, g, S, E);
    float* XS1 = WSP(float, WS_XS1); const float* xs = C.xs;
    const ALoadBf16 AL{WSP(bf16_t, WS_SMIX), D};
    auto Ep = [XS1, xs](int row, int col, float v) { XS1[row * D + col] = xs[row * D + col] + v; };
    for (int it = C.bid; it < D / 32; it += C.G) sgemm32_item(it * 32, D, WSP(bf16_t, WS_WOUT), AL, Ep, (LAS float*)C.lds, C.tid);
}

struct EpiUp {
    static constexpr bool PERM = true, AFTER_DRAIN = false;
    bf16_t* H; const float* ssq; int rowoff;
    __device__ __forceinline__ void operator()(const f32x4 (&acc)[2][2][4][2], const pg8::Unit& u, int wr, int wc, int fr, int fq) const {
        const int row0 = rowoff + u.pm * 256 + wr * 64 + fr, col0 = u.pn * 256 + wc * 32 + 8 * fq;
#pragma unroll
        for (int ai = 0; ai < 2; ++ai)
#pragma unroll
            for (int m = 0; m < 4; ++m) { const int r = row0 + ai * 128 + m * 16;
                const f32x4 p = *(const f32x4*)(ssq + (size_t)r * 16 + 4 * fq); float t = (p.x + p.y) + (p.z + p.w);
                t += __shfl_xor(t, 16); t += __shfl_xor(t, 32);
                const float rstd = rsqrtf(t * (1.f / D) + EPS);
#pragma unroll
                for (int bj = 0; bj < 2; ++bj) { f32x4 v0 = acc[ai][bj][m][0] * rstd, v1 = acc[ai][bj][m][1] * rstd;
#pragma unroll
                    for (int e = 0; e < 4; ++e) { const float a = fmaxf(v0[e], 0.f), b = fmaxf(v1[e], 0.f); v0[e] = a * a; v1[e] = b * b; }
                    u32x4 w; w.x = pkbf(v0[0], v0[1]); w.y = pkbf(v0[2], v0[3]); w.z = pkbf(v1[0], v1[1]); w.w = pkbf(v1[2], v1[3]);
                    *(u32x4*)(H + (size_t)r * FF + col0 + bj * 128) = w; } }
    }
};
__device__ __forceinline__ void p6_up(Ctx& C, int half) {
    const int rowoff = half * (M / 2);
    pg8::Gemm g{WSP(bf16_t, WS_X1B) + (size_t)rowoff * D, WSP(bf16_t, WS_WUP), M / 2, FF, D}; pg8::StaticOrder S; S.init(M / 2, FF, C.G, C.bid);
    EpiUp E{WSP(bf16_t, WS_H), WSP(float, WS_SSQ1), rowoff};
    pg8::gemm_phase<EpiUp, pg8::StaticOrder, true, true>(C.lds, g, S, E);
    if (half == 0 && C.bid < FF / 32) {
        bf16_t* SH = WSP(bf16_t, WS_SH);
        const ALoadF32 AL{WSP(float, WS_XS1), D};
        auto Ep = [SH](int row, int col, float v) { const float a = fmaxf(v, 0.f); SH[row * FF + col] = (bf16_t)(pkbf(a * a, 0.f) & 0xffffu); };
        for (int it = C.bid; it < FF / 32; it += C.G) sgemm32_item(it * 32, D, WSP(bf16_t, WS_WUP), AL, Ep, (LAS float*)C.lds, C.tid);
    }
}

struct EpiDown {
    static constexpr bool PERM = true, AFTER_DRAIN = false;
    float* x1; const bf16_t* x1b; float* ssq; unsigned* cnt; const float* lnw; int rowoff;
    __device__ __forceinline__ void operator()(const f32x4 (&acc)[2][2][4][2], const pg8::Unit& u, int wr, int wc, int fr, int fq) const {
        const int row0 = rowoff + u.pm * 256 + wr * 64 + fr, col0 = u.pn * 256 + wc * 32 + 8 * fq;
        f32x4 v[2][4][2][2];
#pragma unroll
        for (int ai = 0; ai < 2; ++ai)
#pragma unroll
            for (int m = 0; m < 4; ++m) { const int r = row0 + ai * 128 + m * 16; float s = 0.f;
#pragma unroll
                for (int bj = 0; bj < 2; ++bj) { const size_t off = (size_t)r * D + col0 + bj * 128;
                    const u32x4 xb = *(const u32x4*)(x1b + off);
                    const f32x4 v0 = (f32x4){bflo(xb.x), bfhi(xb.x), bflo(xb.y), bfhi(xb.y)} + acc[ai][bj][m][0], v1 = (f32x4){bflo(xb.z), bfhi(xb.z), bflo(xb.w), bfhi(xb.w)} + acc[ai][bj][m][1];
                    v[ai][m][bj][0] = v0; v[ai][m][bj][1] = v1;
                    s += (v0[0] * v0[0] + v0[1] * v0[1]) + (v0[2] * v0[2] + v0[3] * v0[3]) + (v1[0] * v1[0] + v1[1] * v1[1]) + (v1[2] * v1[2] + v1[3] * v1[3]); }
                s += __shfl_xor(s, 16); s += __shfl_xor(s, 32);
                if (fq == 0) __hip_atomic_store(ssq + (size_t)r * 16 + u.pn * 4 + wc, s, __ATOMIC_RELAXED, __HIP_MEMORY_SCOPE_AGENT); }
        asm volatile("s_waitcnt vmcnt(0)" ::: "memory");
        unsigned* cp = cnt + 64 * (u.pm + (rowoff >> 8));
        if ((threadIdx.x & 63) == 0) __hip_atomic_fetch_add(cp, 1u, __ATOMIC_RELAXED, __HIP_MEMORY_SCOPE_AGENT);
        { unsigned spins = 0;
          for (;;) { unsigned v = 0u; if ((threadIdx.x & 63) == 0) v = __hip_atomic_load(cp, __ATOMIC_RELAXED, __HIP_MEMORY_SCOPE_AGENT);
              v = (unsigned)__builtin_amdgcn_readfirstlane((int)v); if (v >= 32u || ++spins > (1u << 18)) break; __builtin_amdgcn_s_sleep(8); } }
        __builtin_amdgcn_fence(__ATOMIC_ACQUIRE, "workgroup");
        f32x4 lw[2][2];
#pragma unroll
        for (int bj = 0; bj < 2; ++bj) { lw[bj][0] = *(const f32x4*)(lnw + col0 + bj * 128); lw[bj][1] = *(const f32x4*)(lnw + col0 + bj * 128 + 4); }
#pragma unroll
        for (int ai = 0; ai < 2; ++ai)
#pragma unroll
            for (int m = 0; m < 4; ++m) { const int r = row0 + ai * 128 + m * 16;
                const float* pp = ssq + (size_t)r * 16 + 4 * fq;
                const float p0 = __hip_atomic_load(pp, __ATOMIC_RELAXED, __HIP_MEMORY_SCOPE_AGENT), p1 = __hip_atomic_load(pp + 1, __ATOMIC_RELAXED, __HIP_MEMORY_SCOPE_AGENT),
                            p2 = __hip_atomic_load(pp + 2, __ATOMIC_RELAXED, __HIP_MEMORY_SCOPE_AGENT), p3 = __hip_atomic_load(pp + 3, __ATOMIC_RELAXED, __HIP_MEMORY_SCOPE_AGENT);
                float t = (p0 + p1) + (p2 + p3);
                t += __shfl_xor(t, 16); t += __shfl_xor(t, 32);
                const float rstd = rsqrtf(t * (1.f / D) + EPS);
#pragma unroll
                for (int bj = 0; bj < 2; ++bj) { const size_t off = (size_t)r * D + col0 + bj * 128;
                    *(f32x4*)(x1 + off) = v[ai][m][bj][0] * rstd * lw[bj][0]; *(f32x4*)(x1 + off + 4) = v[ai][m][bj][1] * rstd * lw[bj][1]; } }
    }
};
__device__ __forceinline__ void p7_down(Ctx& C, int half) {
    const int rowoff = half * (M / 2);
    pg8::Gemm g{WSP(bf16_t, WS_H) + (size_t)rowoff * FF, WSP(bf16_t, WS_WDN), M / 2, D, FF}; pg8::StaticOrder S; S.init(M / 2, D, C.G, C.bid);
    EpiDown E{C.out + O_Y, WSP(bf16_t, WS_X1B), WSP(float, WS_SSQ2), (unsigned*)(C.ws + WS_CTL) + CW_PANEL, C.ln_final, rowoff};
    pg8::gemm_phase<EpiDown, pg8::StaticOrder, true, true>(C.lds, g, S, E);
    if (half != 0) return;
    float* SPART = WSP(float, WS_SPART);
    const ALoadBf16 AL{WSP(bf16_t, WS_SH), FF};
    for (int it = C.bid; it < 8 * (D / 32); it += C.G) { const int cg = it & 31, kp = it >> 5;
        auto Ep = [SPART, kp](int row, int col, float v) { SPART[(kp * SB + row) * D + col] = v; };
        sgemm32_part(cg * 32, kp * (FF / 8), FF / 8, FF, WSP(bf16_t, WS_WDN), AL, Ep, (LAS float*)C.lds, C.tid); }
}

__device__ __forceinline__ void p8_final(Ctx& C) {
    const int gw = C.bid * NWAVES + C.wave, NGW = C.G * NWAVES, lane = C.lane;
    f32x4 lw[4];
#pragma unroll
    for (int j = 0; j < 4; ++j) lw[j] = ((const f32x4*)C.ln_final)[64 * j + lane];
    const float* XS1 = WSP(float, WS_XS1); const float* SPART = WSP(float, WS_SPART); float* YS = C.out + O_YS;
    for (int row = gw; row < SB; row += NGW) {
        f32x4 v[4], d[4]; float s1 = 0.f;
#pragma unroll
        for (int j = 0; j < 4; ++j) { v[j] = ((const f32x4*)(XS1 + row * D))[64 * j + lane]; s1 += (v[j].x * v[j].x + v[j].y * v[j].y) + (v[j].z * v[j].z + v[j].w * v[j].w); d[j] = (f32x4){0.f, 0.f, 0.f, 0.f}; }
#pragma unroll
        for (int kp = 0; kp < 8; ++kp)
#pragma unroll
            for (int j = 0; j < 4; ++j) d[j] += ((const f32x4*)(SPART + (size_t)(kp * SB + row) * D))[64 * j + lane];
        s1 = wave_sum(s1); const float r1 = rsqrtf(s1 * (1.f / D) + EPS), r2 = r1 * r1;
        float s = 0.f;
#pragma unroll
        for (int j = 0; j < 4; ++j) { v[j] += d[j] * r2; s += (v[j].x * v[j].x + v[j].y * v[j].y) + (v[j].z * v[j].z + v[j].w * v[j].w); }
        s = wave_sum(s); const float rstd = rsqrtf(s * (1.f / D) + EPS);
#pragma unroll
        for (int j = 0; j < 4; ++j) ((f32x4*)(YS + row * D))[64 * j + lane] = v[j] * rstd * lw[j];
    }
}

#ifndef MK_PER_PHASE
#define MK_PER_PHASE 0
#endif
constexpr int N_PHASES = 9;
struct Args { const float* in[17]; float* out; unsigned char* ws; int ph_lo, ph_hi; };
__global__ void __launch_bounds__(NTHREADS, 2) mk_fwd(Args args) {
    extern __shared__ __attribute__((aligned(16))) unsigned char lds_raw[];
    Ctx C;
    C.lds = (LAS unsigned char*)lds_raw;
    C.tid = threadIdx.x; C.lane = C.tid & 63; C.wave = __builtin_amdgcn_readfirstlane(C.tid >> 6); C.G = gridDim.x; C.bid = blockIdx.x;
    C.x = args.in[0]; C.xs = args.in[1]; C.st_conv = args.in[2]; C.st_ssm = args.in[3]; C.ck = args.in[4]; C.cv = args.in[5]; C.ln_mix = args.in[6]; C.w_in = args.in[7];
    C.conv_w = args.in[8]; C.a_log = args.in[9]; C.dt_bias = args.in[10]; C.dn_norm = args.in[11]; C.w_out = args.in[12]; C.ln_ffn = args.in[13]; C.w_up = args.in[14];
    C.w_dn = args.in[15]; C.ln_final = args.in[16]; C.out = args.out; C.ws = args.ws;
    volatile LAS unsigned* MISC = (volatile LAS unsigned*)(C.lds + MISC_OFF);
    for (int u = C.tid; u < (LDS_BYTES - LDSCTL_OFF) / 4; u += NTHREADS) ((LAS unsigned*)(C.lds + LDSCTL_OFF))[u] = 0u;
    __syncthreads();
    XcdBarrier bar; bar.bar = (unsigned*)(C.ws + WS_CTL) + CW_BAR; bar.x = 0; bar.st = nullptr;
    if (!MK_PER_PHASE) bar = xcd_barrier_post((unsigned*)(C.ws + WS_CTL) + CW_BAR, MISC + 8);
    const int lo = args.ph_lo, hi = args.ph_hi;
#define IN(k) (lo <= (k) && (k) < hi)
#define SEAM(k) do { if (IN(k) && IN((k) + 1)) xcd_barrier(bar); } while (0)
    if (IN(0)) p0_prologue(C);
    SEAM(0);
    if (IN(1)) p1_inproj(C);
    SEAM(1);
    if (IN(2)) p2_mixprep(C);
    SEAM(2);
    if (IN(3)) p3_scan(C);
    SEAM(3);
    if (IN(4)) p4_combine(C);
    SEAM(4);
    if (IN(5)) p5_outproj(C);
    SEAM(5);
    if (IN(6)) p6_up(C, 0);
    SEAM(6);
    if (IN(7)) { p7_down(C, 0); p6_up(C, 1); }
    SEAM(7);
    if (IN(8)) { p7_down(C, 1); p8_final(C); }
#undef IN
#undef SEAM
}

extern "C" void kernel_launch(void* const* d_in, const int* in_sizes, int n_in, void* d_out, int out_size, void* d_ws, size_t ws_size, hipStream_t stream) {
    static int grid = 0;
    if (grid == 0) {
        if (n_in != 17 || (size_t)out_size != O_END || ws_size < WS_END) { fprintf(stderr, "kernel_launch: unexpected shapes (n_in %d out %d ws %zu)\n", n_in, out_size, ws_size); grid = -1; return; }
        int dev = 0, cus = 0;
        if (hipGetDevice(&dev) != hipSuccess || hipDeviceGetAttribute(&cus, hipDeviceAttributeMultiprocessorCount, dev) != hipSuccess) { grid = -1; return; }
        if (hipFuncSetAttribute((const void*)mk_fwd, hipFuncAttributeMaxDynamicSharedMemorySize, LDS_BYTES) != hipSuccess) { fprintf(stderr, "kernel_launch: hipFuncSetAttribute failed\n"); grid = -1; return; }
        int per_cu = 0;
        (void)hipOccupancyMaxActiveBlocksPerMultiprocessor(&per_cu, (const void*)mk_fwd, NTHREADS, LDS_BYTES);
        (void)hipGetLastError();
        grid = cus;
        if (grid != 256) fprintf(stderr, "kernel_launch: note: %d CUs (built for 256)\n", grid);
    }
    if (grid < 0) return;
    (void)hipMemsetAsync((char*)d_ws + WS_CTL, 0, CTL_ZERO_BYTES, stream);
    Args a{};
    for (int i = 0; i < 17; ++i) a.in[i] = (const float*)d_in[i];
    a.out = (float*)d_out; a.ws = (unsigned char*)d_ws;
#if MK_PER_PHASE
    for (int p = 0; p < N_PHASES; ++p) { a.ph_lo = p; a.ph_hi = p + 1; hipLaunchKernelGGL(mk_fwd, dim3(grid), dim3(NTHREADS), LDS_BYTES, stream, a); }
#else
    a.ph_lo = 0; a.ph_hi = N_PHASES; hipLaunchKernelGGL(mk_fwd, dim3(grid), dim3(NTHREADS), LDS_BYTES, stream, a);
#endif
}
```

```cpp
#include <hip/hip_runtime.h>
#include <cstdio>
#include <cstdint>
namespace pg8 {
#define PG8_LAS __attribute__((address_space(3)))
typedef unsigned short bf16_t;
typedef short bf16x8 __attribute__((ext_vector_type(8)));
typedef float f32x4 __attribute__((ext_vector_type(4)));
typedef unsigned u32x4 __attribute__((ext_vector_type(4)));
constexpr int BM = 256, BK = 64, HALF = 128, HTB = HALF * BK * 2  , STAGE_BYTES = 8 * HTB, NXCD = 8, WGM = 8;

__host__ __device__ __forceinline__ int lds_byte(int r, int c) { const int st = (r >> 4) * 2 + (c >> 5), rr = r & 15, cc = c & 31, ob = rr * 64 + cc * 2; return st * 1024 + (ob ^ (((ob >> 9) & 1) << 5)); }
__host__ __device__ __forceinline__ void stage_rc(int b, int& R, int& C) { const int st = b / 1024, sb = b % 1024, swz = sb ^ (((sb >> 9) & 1) << 5); R = (st >> 1) * 16 + swz / 64; C = (st & 1) * 32 + (swz % 64) / 2; }
__host__ __device__ __forceinline__ int perm32(int rho) { const int n = rho >> 4, i = rho & 15; return 8 * (i >> 2) + 4 * n + (i & 3); }

struct Unit { int pm, pn; };
struct Gemm { const bf16_t* A; const bf16_t* Bt; int M, N, K; };

struct StaticOrder {
    int nM, nN, nwg, G, c;
    __host__ __device__ void init(int M, int N, int G_, int c_) { nM = M / BM; nN = N / BM; nwg = nM * nN; G = G_; c = c_; }
    __host__ __device__ bool next(int i, Unit& u) const {
        const long L = (long)i * G + c; if (L >= nwg) return false;
        int wgid = (int)L; { const int q = nwg / NXCD, r = nwg % NXCD, xcd = wgid % NXCD, off = wgid / NXCD; wgid = (xcd < r ? xcd * (q + 1) : r * (q + 1) + (xcd - r) * q) + off; }
        const int nig = WGM * nN, gid = wgid / nig, fm = gid * WGM, gsz = (nM - fm) < WGM ? (nM - fm) : WGM;
        u.pm = fm + ((wgid % nig) % gsz); u.pn = (wgid % nig) / gsz; return true;
    }
    __device__ __forceinline__ void a_ready(const Unit&) const {}
    __device__ __forceinline__ void done(const Unit&) const {}
};

template <class Epi, class Sched, bool ALIGN_EPI = false, bool SP2 = false>
__device__ __forceinline__ void gemm_phase(PG8_LAS unsigned char* lds, const Gemm g, const Sched& S, const Epi& E) {
    const int tid = threadIdx.x, wid = __builtin_amdgcn_readfirstlane(tid >> 6), lane = tid & 63, wr = wid >> 2, wc = wid & 3, fr = lane & 15, fq = lane >> 4;
    const int K = g.K, nt = K / BK;
    unsigned voffA[2], voffB[2];
#pragma unroll
    for (int i = 0; i < 2; ++i) { int R, C; stage_rc(tid * 16 + i * 8192, R, C); const int Rb = Epi::PERM ? ((R & ~31) + perm32(R & 31)) : R;
        voffA[i] = (unsigned)(R * K + C) * 2u; voffB[i] = (unsigned)(Rb * K + C) * 2u; }
    const size_t kstep = (size_t)(BK * 2);
    const size_t hstep = (size_t)HALF * K * 2;
    const size_t tstep = 2 * hstep;
    const unsigned ldsw = (unsigned)wid * 1024u;
    const int aoff = lds_byte(wr * 64 + fr, fq * 8), boff = lds_byte(wc * 32 + fr, fq * 8);
#define PG8_SA(b, h) (((b) * 2 + (h)) * HTB)
#define PG8_SB(b, h) ((4 + (b) * 2 + (h)) * HTB)
#define PG8_STAGE(bufoff, gbase, voff) do { _Pragma("unroll") for (int _i = 0; _i < 2; ++_i) \
        __builtin_amdgcn_global_load_lds((const unsigned*)((const char*)(gbase) + (voff)[_i]), (PG8_LAS unsigned*)(lds + (bufoff) + ldsw + _i * 8192), 16, 0, 0); } while (0)
#define PG8_LDA(dst, b, h) do { _Pragma("unroll") for (int m = 0; m < 4; ++m) _Pragma("unroll") for (int k = 0; k < 2; ++k) dst[m][k] = *(const PG8_LAS bf16x8*)(lds + PG8_SA(b, h) + aoff + m * 2048 + k * 1024); } while (0)
#define PG8_LDB(dst, b, h) do { _Pragma("unroll") for (int n = 0; n < 2; ++n) _Pragma("unroll") for (int k = 0; k < 2; ++k) dst[n][k] = *(const PG8_LAS bf16x8*)(lds + PG8_SB(b, h) + boff + n * 2048 + k * 1024); } while (0)
#define PG8_MMA(ai, bj, At, Bt) do { __builtin_amdgcn_s_setprio(1); _Pragma("unroll") for (int m = 0; m < 4; ++m) _Pragma("unroll") for (int n = 0; n < 2; ++n) _Pragma("unroll") for (int k = 0; k < 2; ++k) \
        acc[ai][bj][m][n] = __builtin_amdgcn_mfma_f32_16x16x32_bf16(Bt[n][k], At[m][k], acc[ai][bj][m][n], 0, 0, 0); __builtin_amdgcn_s_setprio(0); } while (0)
#define PG8_WAIT_V(n) asm volatile("s_waitcnt vmcnt(" #n ")" ::: "memory")
#define PG8_WAIT_L(n) asm volatile("s_waitcnt lgkmcnt(" #n ")" ::: "memory")
#define PG8_BAR __builtin_amdgcn_s_barrier()
#define PG8_SCHED __builtin_amdgcn_sched_barrier(0)
    Unit cur, nxt; int ui = 0;
    if (!S.next(0, cur)) return;
    f32x4 acc[2][2][4][2];
#pragma unroll
    for (int a = 0; a < 2; ++a)
#pragma unroll
        for (int b = 0; b < 2; ++b)
#pragma unroll
            for (int m = 0; m < 4; ++m)
#pragma unroll
                for (int n = 0; n < 2; ++n) acc[a][b][m][n] = (f32x4){0.f, 0.f, 0.f, 0.f};
    bf16x8 At[4][2], B0[2][2], B1[2][2];
    const char* cA = (const char*)g.A + (size_t)cur.pm * tstep; const char* cB = (const char*)g.Bt + (size_t)cur.pn * tstep;
    S.a_ready(cur);
    if constexpr (SP2) {
        PG8_STAGE(PG8_SB(0, 0), cB, voffB); PG8_STAGE(PG8_SB(0, 1), cB + hstep, voffB); PG8_STAGE(PG8_SA(0, 0), cA, voffA); PG8_STAGE(PG8_SA(0, 1), cA + hstep, voffA);
        if (wr == 1) PG8_BAR;
        PG8_WAIT_V(2); PG8_BAR;
        PG8_STAGE(PG8_SB(1, 0), cB + kstep, voffB); PG8_STAGE(PG8_SA(1, 0), cA + kstep, voffA); PG8_STAGE(PG8_SB(1, 1), cB + hstep + kstep, voffB);
        PG8_WAIT_V(6); PG8_BAR;
    } else {
        PG8_STAGE(PG8_SB(0, 0), cB, voffB); PG8_STAGE(PG8_SA(0, 0), cA, voffA); PG8_STAGE(PG8_SB(0, 1), cB + hstep, voffB); PG8_STAGE(PG8_SA(0, 1), cA + hstep, voffA);
        if (wr == 1) PG8_BAR;
        PG8_WAIT_V(4); PG8_BAR;
        PG8_STAGE(PG8_SB(1, 0), cB + kstep, voffB); PG8_STAGE(PG8_SA(1, 0), cA + kstep, voffA); PG8_STAGE(PG8_SB(1, 1), cB + hstep + kstep, voffB);
        PG8_WAIT_V(6); PG8_BAR;
    }
    for (;;) {
        const bool has_next = S.next(ui + 1, nxt);
        const char* nA = has_next ? (const char*)g.A + (size_t)nxt.pm * tstep : cA; const char* nB = has_next ? (const char*)g.Bt + (size_t)nxt.pn * tstep : cB;
        for (int t = 0; t < nt; t += 2) {
            const bool last = (t == nt - 2);
            const char* a1 = cA + (size_t)(t + 1) * kstep;
            const char* a2 = last ? nA : cA + (size_t)(t + 2) * kstep; const char* b2 = last ? nB : cB + (size_t)(t + 2) * kstep;
            const char* a3 = a2 + kstep; const char* b3 = b2 + kstep;
            if (last && has_next) S.a_ready(nxt);
            if constexpr (SP2) {
            PG8_LDB(B0, 0, 0); PG8_LDB(B1, 0, 1); PG8_SCHED; PG8_LDA(At, 0, 0); PG8_STAGE(PG8_SA(1, 1), a1 + hstep, voffA);
            PG8_WAIT_V(8); PG8_WAIT_L(0); PG8_BAR; PG8_MMA(0, 0, At, B0); PG8_MMA(0, 1, At, B1); PG8_BAR; PG8_SCHED;
            PG8_LDA(At, 0, 1); PG8_STAGE(PG8_SB(0, 0), b2, voffB); PG8_STAGE(PG8_SB(0, 1), b2 + hstep, voffB); PG8_STAGE(PG8_SA(0, 0), a2, voffA);
            PG8_WAIT_V(8); PG8_WAIT_L(0); PG8_BAR; PG8_MMA(1, 0, At, B0); PG8_MMA(1, 1, At, B1); PG8_BAR; PG8_SCHED;
            PG8_LDB(B0, 1, 0); PG8_LDB(B1, 1, 1); PG8_SCHED; PG8_LDA(At, 1, 0); PG8_STAGE(PG8_SA(0, 1), a2 + hstep, voffA);
            PG8_WAIT_V(8); PG8_WAIT_L(0); PG8_BAR; PG8_MMA(0, 0, At, B0); PG8_MMA(0, 1, At, B1); PG8_BAR; PG8_SCHED;
            PG8_LDA(At, 1, 1); PG8_STAGE(PG8_SB(1, 0), b3, voffB); PG8_STAGE(PG8_SB(1, 1), b3 + hstep, voffB); PG8_STAGE(PG8_SA(1, 0), a3, voffA);
            PG8_WAIT_V(8); PG8_WAIT_L(0); PG8_BAR; PG8_MMA(1, 0, At, B0); PG8_MMA(1, 1, At, B1); PG8_BAR; PG8_SCHED;
            } else {
            PG8_LDB(B0, 0, 0); PG8_SCHED; PG8_LDA(At, 0, 0); PG8_STAGE(PG8_SA(1, 1), a1 + hstep, voffA);
            PG8_WAIT_L(8); PG8_BAR; PG8_WAIT_L(0); PG8_MMA(0, 0, At, B0); PG8_BAR; PG8_SCHED;
            PG8_LDB(B1, 0, 1); PG8_STAGE(PG8_SB(0, 0), b2, voffB);
            PG8_BAR; PG8_WAIT_L(0); PG8_MMA(0, 1, At, B1); PG8_BAR;
            PG8_LDA(At, 0, 1); PG8_STAGE(PG8_SA(0, 0), a2, voffA);
            PG8_BAR; PG8_WAIT_L(0); PG8_MMA(1, 0, At, B0); PG8_BAR; PG8_SCHED;
            PG8_STAGE(PG8_SB(0, 1), b2 + hstep, voffB);
            PG8_WAIT_V(6); PG8_BAR; PG8_MMA(1, 1, At, B1); PG8_BAR;
            PG8_LDB(B0, 1, 0); PG8_SCHED; PG8_LDA(At, 1, 0); PG8_STAGE(PG8_SA(0, 1), a2 + hstep, voffA);
            PG8_WAIT_L(8); PG8_BAR; PG8_WAIT_L(0); PG8_MMA(0, 0, At, B0); PG8_BAR; PG8_SCHED;
            PG8_LDB(B1, 1, 1); PG8_STAGE(PG8_SB(1, 0), b3, voffB);
            PG8_BAR; PG8_WAIT_L(0); PG8_MMA(0, 1, At, B1); PG8_BAR;
            PG8_LDA(At, 1, 1); PG8_STAGE(PG8_SA(1, 0), a3, voffA);
            PG8_BAR; PG8_WAIT_L(0); PG8_MMA(1, 0, At, B0); PG8_BAR; PG8_SCHED;
            PG8_STAGE(PG8_SB(1, 1), b3 + hstep, voffB);
            PG8_WAIT_V(6); PG8_BAR; PG8_MMA(1, 1, At, B1); PG8_BAR;
            }
        }
        if constexpr (ALIGN_EPI) { if (wr == 0) PG8_BAR; }
        if constexpr (!Epi::AFTER_DRAIN) { E(acc, cur, wr, wc, fr, fq); S.done(cur); }
        if (!has_next) break;
#pragma unroll
        for (int a = 0; a < 2; ++a)
#pragma unroll
            for (int b = 0; b < 2; ++b)
#pragma unroll
                for (int m = 0; m < 4; ++m)
#pragma unroll
                    for (int n = 0; n < 2; ++n) acc[a][b][m][n] = (f32x4){0.f, 0.f, 0.f, 0.f};
        cur = nxt; cA = nA; cB = nB; ++ui;
        if constexpr (ALIGN_EPI) { if (wr == 1) PG8_BAR; }
    }
    PG8_WAIT_V(0);
    if constexpr (!ALIGN_EPI) { if (wr == 0) PG8_BAR; }
    PG8_BAR;
    if constexpr (Epi::AFTER_DRAIN) { E.fused(acc, cur, wr, wc, fr, fq, lds, wid, lane); S.done(cur); }
#undef PG8_SA
#undef PG8_SB
#undef PG8_STAGE
#undef PG8_LDA
#undef PG8_LDB
#undef PG8_MMA
#undef PG8_WAIT_V
#undef PG8_WAIT_L
#undef PG8_BAR
#undef PG8_SCHED
}
}
#define LAS __attribute__((address_space(3)))
#define XB_TMO      128
#define XB_XCNT(j)  (256  + 64 * (j))
#define XB_XSUB(j)  (1280 + 64 * (j))
#define XB_XGEN(j)  (2304 + 64 * (j))
#define XB_TOP      3328
#define XB_TOPGEN   3392
#define XCD_BAR_WORDS 3456
#define XB_SPIN_CAP (1u << 18)

__device__ __forceinline__ unsigned xb_ld(unsigned* p)              { return __hip_atomic_load(p, __ATOMIC_RELAXED, __HIP_MEMORY_SCOPE_AGENT); }
__device__ __forceinline__ unsigned xb_add(unsigned* p, unsigned v) { return __hip_atomic_fetch_add(p, v, __ATOMIC_RELAXED, __HIP_MEMORY_SCOPE_AGENT); }
__device__ __forceinline__ unsigned xb_xcc_id() { return (unsigned)__builtin_amdgcn_s_getreg((3 << 11) | 20) & 0xFu; }
#define XB_SPIN(cond, bar) do { unsigned _sp = 0; while (cond) { __builtin_amdgcn_s_sleep(1); \
    if ((++_sp & 255u) == 0u) { if (xb_ld(&(bar)[XB_TMO])) break; if (_sp > XB_SPIN_CAP) { atomicAdd(&(bar)[XB_TMO], 1u); break; } } } } while (0)

struct XcdBarrier {
    unsigned* bar; unsigned x;
    volatile LAS unsigned* st;
};

__device__ __forceinline__ XcdBarrier xcd_barrier_post(unsigned* bar, volatile LAS unsigned* st) {
    XcdBarrier b; b.bar = bar; b.x = xb_xcc_id(); b.st = st;
    if (threadIdx.x == 0) (void)xb_add(&bar[XB_XCNT(b.x)], 1u);
    return b;
}
__device__ __forceinline__ void xcd_barrier_complete(unsigned* bar, unsigned x, unsigned& nloc, unsigned& nx) {
    const unsigned G = gridDim.x * gridDim.y * gridDim.z;
    unsigned sum, cnt, mine, sp = 0u;
    for (;;) {
        sum = 0u; cnt = 0u; mine = 0u;
#pragma unroll
        for (unsigned j = 0; j < 16; ++j) { const unsigned c = xb_ld(&bar[XB_XCNT(j)]); sum += c; cnt += (c > 0u) ? 1u : 0u; mine = (j == x) ? c : mine; }
        if (sum == G) break;
        __builtin_amdgcn_s_sleep(1);
        if ((++sp & 255u) == 0u) { if (xb_ld(&bar[XB_TMO])) break; if (sp > XB_SPIN_CAP) { atomicAdd(&bar[XB_TMO], 1u); break; } }
    }
    nloc = mine > 0u ? mine : 1u; nx = cnt > 0u ? cnt : 1u;
}

__device__ __forceinline__ void xcd_barrier(const XcdBarrier& b) {
    asm volatile("s_waitcnt vmcnt(0)" ::: "memory");
    __syncthreads();
    if (threadIdx.x == 0) {
        unsigned* bar = b.bar;
        __builtin_amdgcn_s_waitcnt(0);
        unsigned nloc = b.st[0], nx = b.st[1];
        if (nloc == 0u) { xcd_barrier_complete(bar, b.x, nloc, nx); b.st[0] = nloc; b.st[1] = nx; }
        const unsigned old = xb_add(&bar[XB_XSUB(b.x)], 1u);
        const unsigned gen = old / nloc;
        if (old + 1u == (gen + 1u) * nloc) {
            __builtin_amdgcn_fence(__ATOMIC_RELEASE, "agent");
            asm volatile("s_waitcnt vmcnt(0)" ::: "memory");
            const unsigned og = xb_add(&bar[XB_TOP], 1u);
            const unsigned tg = og / nx, goal = (tg + 1u) * nx;
            if (og + 1u != goal) XB_SPIN(xb_ld(&bar[XB_TOP]) < goal, bar);
            xb_add(&bar[XB_XGEN(b.x)], 1u);
            __builtin_amdgcn_fence(__ATOMIC_ACQUIRE, "agent");
            asm volatile("s_waitcnt vmcnt(0)" ::: "memory");
        } else {
            XB_SPIN(xb_ld(&bar[XB_XGEN(b.x)]) == gen, bar);
            __builtin_amdgcn_fence(__ATOMIC_ACQUIRE, "agent");
            asm volatile("s_waitcnt vmcnt(0)" ::: "memory");
        }
    }
    __syncthreads();
}
#undef LAS

#define GAS __attribute__((address_space(1)))
#define LAS __attribute__((address_space(3)))
using pg8::bf16_t; using pg8::bf16x8; using pg8::f32x4; using pg8::u32x4;
typedef float f32x16 __attribute__((ext_vector_type(16)));
typedef float f32x2 __attribute__((ext_vector_type(2)));
typedef unsigned u32x2 __attribute__((ext_vector_type(2)));
typedef short s16x4 __attribute__((ext_vector_type(4)));

constexpr int NWAVES = 8, NTHREADS = 512;
constexpr int D = 1024, NB = 8, SEQ = 4096, M = NB * SEQ, SB = 32;
constexpr int CONV_CH = 1536, NHD = 4, DK = 128, DV = 128, ATH = 8, ATD = 64, ATW = 512;
constexpr int IN_DIM = 3592, NIN = 3584, FF = 4096, WIN = 2048, NCH = SEQ / 64;
constexpr float EPS = 1e-6f;
constexpr float LOG2E = 1.4426950408889634f;
constexpr float QSCALE = 0.125f * LOG2E;

constexpr size_t O_Y = 0, O_YS = 33554432, O_PCONV = 33587200, O_PSSM = 33624064, O_PWK = 34148352, O_PWV = 42536960,
                 O_SCONV = 50925568, O_SSSM = 51073024, O_SWK = 53170176, O_SWV = 86724608, O_END = 120279040;

constexpr size_t MiB = 1u << 20;
constexpr size_t WS_CTL = 0, CTL_ZERO_BYTES = 128 * 1024;
constexpr size_t WS_WIN = 2 * MiB, WS_WOUT = 10 * MiB, WS_WUP = 12 * MiB, WS_WDN = 20 * MiB;
constexpr size_t WS_BETA = 28 * MiB, WS_GG = WS_BETA + 512 * 1024, WS_EGL = 29 * MiB;
constexpr size_t WS_SSQ1 = 30 * MiB, WS_SSQ2 = 32 * MiB, WS_LSE = 34 * MiB;
constexpr size_t WS_S = 37 * MiB;
constexpr size_t WS_XSN = WS_S, WS_SGATE = WS_S + 64 * 1024, WS_SPROJ = WS_S + 128 * 1024, WS_SMIX = WS_S + 640 * 1024,
                 WS_XS1 = WS_S + 704 * 1024, WS_SH = WS_S + 832 * 1024, WS_XS2 = WS_S + 1088 * 1024, WS_SATT = WS_S + 1280 * 1024;
constexpr size_t WS_SPART = 39 * MiB;
constexpr size_t WS_XN = 40 * MiB;
constexpr size_t WS_O1 = 40 * MiB, WS_O2 = 72 * MiB, WS_X1B = 40 * MiB;
constexpr size_t WS_PRE = 104 * MiB;
constexpr size_t WS_MIX = 104 * MiB, WS_H = 104 * MiB;
constexpr size_t WS_Z = 200 * MiB;
constexpr size_t WS_QA = 232 * MiB, WS_KA = 264 * MiB, WS_VA = 296 * MiB;
constexpr size_t WS_ORAW = 168 * MiB;
constexpr size_t WS_GDN = 328 * MiB;
constexpr size_t WS_O3 = 472 * MiB;
constexpr size_t WS_END = 504 * MiB;
constexpr int GDN_CHUNK_BYTES = 73728;
constexpr int GI_NW = 0, GI_QG = 16384, GI_QK = 32768, GI_KD = 40960, GI_U = 57344;

constexpr int CW_TMO = 0, CW_BAR = 4096, CW_PANEL = 16384;

constexpr int RING_BYTES = 131072, LDSCTL_OFF = 159744, MISC_OFF = LDSCTL_OFF + 320, LDS_BYTES = 160768;

#define LDS_WAIT() asm volatile("s_waitcnt lgkmcnt(0)" ::: "memory")
#define VM_WAIT() asm volatile("s_waitcnt vmcnt(0)" ::: "memory")

__device__ __forceinline__ unsigned pkbf(float lo, float hi) {
    typedef __bf16 bf2_t __attribute__((ext_vector_type(2)));
    f32x2 v = {lo, hi}; bf2_t b = __builtin_convertvector(v, bf2_t); return __builtin_bit_cast(unsigned, b);
}
__device__ __forceinline__ float bflo(unsigned u) { return __uint_as_float(u << 16); }
__device__ __forceinline__ float bfhi(unsigned u) { return __uint_as_float(u & 0xffff0000u); }
__device__ __forceinline__ float wave_sum(float v) {
#pragma unroll
    for (int o = 1; o < 64; o <<= 1) v += __shfl_xor(v, o);
    return v;
}
__device__ __forceinline__ float siluf(float x) { return x * __builtin_amdgcn_rcpf(1.f + __expf(-x)); }
__device__ __forceinline__ float sigmoidf_(float x) { return 1.f / (1.f + __expf(-x)); }
__device__ __forceinline__ float softplusf_(float x) { return x > 20.f ? x : log1pf(__expf(x)); }


struct Ctx {
    LAS unsigned char* lds;
    int tid, lane, wave, G, bid;
    const float *x, *xs, *st_conv, *st_ssm, *ck, *cv, *ln_mix, *w_in, *conv_w, *a_log, *dt_bias, *dn_norm, *w_out, *ln_ffn, *w_up, *w_dn, *ln_final;
    float* out; unsigned char* ws;
};
#define WSP(T, off) ((T*)(C.ws + (off)))

__device__ __forceinline__ void transpose_item(const float* __restrict__ W, int ldw, int srccol0, int k0, const float* __restrict__ kscale, bf16_t* WT, int K, int dstrow0, LAS float* scr, int lane) {
    float tv[32];
#pragma unroll
    for (int i = 0; i < 32; ++i) tv[i] = W[(size_t)(k0 + 2 * i + (lane >> 5)) * ldw + srccol0 + (lane & 31)];
#pragma unroll
    for (int i = 0; i < 32; ++i) { const int kk = 2 * i + (lane >> 5); float v = tv[i]; if (kscale) v *= kscale[k0 + kk]; scr[kk * 33 + (lane & 31)] = v; }
    LDS_WAIT(); asm volatile("" ::: "memory");
    const int c = lane & 7;
#pragma unroll
    for (int j = 0; j < 4; ++j) { const int n = (lane >> 3) + 8 * j; const LAS float* s = scr + (8 * c) * 33 + n;
        u32x4 o; o.x = pkbf(s[0 * 33], s[1 * 33]); o.y = pkbf(s[2 * 33], s[3 * 33]); o.z = pkbf(s[4 * 33], s[5 * 33]); o.w = pkbf(s[6 * 33], s[7 * 33]);
        *(u32x4*)(WT + (size_t)(dstrow0 + n) * K + k0 + 8 * c) = o; }
    LDS_WAIT(); asm volatile("" ::: "memory");
}

__device__ __forceinline__ void late_weight_copies(Ctx& C, int part, int nparts) {
    const int gw = part * NWAVES + C.wave, NGW = nparts * NWAVES, lane = C.lane;
    LAS float* scr = (LAS float*)(C.lds + C.wave * 16384);
    constexpr int I_OUT = (D / 64) * (D / 32), I_UP = (D / 64) * (FF / 32), I_DN = (FF / 64) * (D / 32);
    for (int it = gw; it < I_OUT + I_UP + I_DN; it += NGW) {
        const int q9 = it / 9, m9 = it % 9;
        if (m9 == 0) { const int r = q9; const int nblk = D / 32, kb = r / nblk, nb = r % nblk;
            transpose_item(C.w_out, D, nb * 32, 64 * kb, nullptr, WSP(bf16_t, WS_WOUT), D, nb * 32, scr, lane); }
        else if (m9 < 5) { const int r = q9 * 4 + (m9 - 1); const int nblk = FF / 32, kb = r / nblk, nb = r % nblk;
            transpose_item(C.w_up, FF, nb * 32, 64 * kb, C.ln_ffn, WSP(bf16_t, WS_WUP), D, nb * 32, scr, lane); }
        else { const int r = q9 * 4 + (m9 - 5); const int nblk = D / 32, kb = r / nblk, nb = r % nblk;
            transpose_item(C.w_dn, D, nb * 32, 64 * kb, nullptr, WSP(bf16_t, WS_WDN), FF, nb * 32, scr, lane); }
    }
    __syncthreads();
}
__device__ __forceinline__ void p0_prologue(Ctx& C) {
    const int gw = C.bid * NWAVES + C.wave, NGW = C.G * NWAVES, lane = C.lane;
    {
        LAS float* scr = (LAS float*)(C.lds + C.wave * 16384);
        constexpr int I_IN = (D / 64) * (NIN / 32);
        for (int it = gw; it < I_IN; it += NGW) { const int nblk = NIN / 32, kb = it / nblk, nb = it % nblk; const int src = nb * 32 + (nb >= 64 ? 8 : 0);
            transpose_item(C.w_in, IN_DIM, src, 64 * kb, nullptr, WSP(bf16_t, WS_WIN), D, nb * 32, scr, lane); }
    }
    __syncthreads();
    LAS float* wg = (LAS float*)C.lds;
    for (int idx = C.tid; idx < 8192; idx += NTHREADS) { const int k = idx >> 3, g = idx & 7; wg[g * 1024 + k] = C.w_in[(size_t)k * IN_DIM + 2048 + g]; }
    __syncthreads();
    f32x4 lw[4];
#pragma unroll
    for (int j = 0; j < 4; ++j) lw[j] = ((const f32x4*)C.ln_mix)[64 * j + lane];
    bf16_t* XN = WSP(bf16_t, WS_XN); bf16_t* XSN = WSP(bf16_t, WS_XSN);
    float* BETA = WSP(float, WS_BETA); float* GG = WSP(float, WS_GG); float* SG = WSP(float, WS_SGATE);
    for (int row = gw; row < M + SB; row += NGW) {
        const bool smp = row >= M;
        const float* xr = smp ? C.xs + (size_t)(row - M) * D : C.x + (size_t)row * D;
        f32x4 v[4]; float s = 0.f;
#pragma unroll
        for (int j = 0; j < 4; ++j) { v[j] = ((const f32x4*)xr)[64 * j + lane]; s += (v[j].x * v[j].x + v[j].y * v[j].y) + (v[j].z * v[j].z + v[j].w * v[j].w); }
        s = wave_sum(s);
        const float rstd = rsqrtf(s * (1.f / D) + EPS);
#pragma unroll
        for (int j = 0; j < 4; ++j) v[j] = v[j] * rstd * lw[j];
        bf16_t* orow = smp ? XSN + (size_t)(row - M) * D : XN + (size_t)row * D;
#pragma unroll
        for (int j = 0; j < 4; ++j) { u32x2 o; o.x = pkbf(v[j].x, v[j].y); o.y = pkbf(v[j].z, v[j].w); ((u32x2*)orow)[64 * j + lane] = o; }
        float a[8];
#pragma unroll
        for (int g = 0; g < 8; ++g) { float t = 0.f;
#pragma unroll
            for (int j = 0; j < 4; ++j) { const f32x4 w = ((const LAS f32x4*)wg)[g * 256 + 64 * j + lane]; t += (v[j].x * w.x + v[j].y * w.y) + (v[j].z * w.z + v[j].w * w.w); }
            a[g] = t; }
        { const bool hi = lane & 1;
#pragma unroll
          for (int i = 0; i < 4; ++i) { const float keep = hi ? a[i + 4] : a[i], send = hi ? a[i] : a[i + 4]; a[i] = keep + __shfl_xor(send, 1); } }
        { const bool hi = lane & 2;
#pragma unroll
          for (int i = 0; i < 2; ++i) { const float keep = hi ? a[i + 2] : a[i], send = hi ? a[i] : a[i + 2]; a[i] = keep + __shfl_xor(send, 2); } }
        { const bool hi = lane & 4; const float keep = hi ? a[1] : a[0], send = hi ? a[0] : a[1]; a[0] = keep + __shfl_xor(send, 4); }
        float gv = a[0]; gv += __shfl_xor(gv, 8); gv += __shfl_xor(gv, 16); gv += __shfl_xor(gv, 32);
        if (lane < 8) {
            const int gi = 4 * (lane & 1) + 2 * ((lane >> 1) & 1) + ((lane >> 2) & 1);
            float o;
            if (gi < 4) o = sigmoidf_(gv);
            else { const int h = gi - 4; o = -__expf(C.a_log[h]) * softplusf_(gv + C.dt_bias[h]); }
            if (smp) SG[(row - M) * 8 + gi] = o;
            else if (gi < 4) BETA[(size_t)row * 4 + gi] = o; else GG[(size_t)row * 4 + (gi - 4)] = o;
        }
    }
    __syncthreads();
}

template <class ALoad, class Epi>
__device__ __forceinline__ void sgemm32_part(int n0, int kb, int kl, int ldw, const bf16_t* __restrict__ WT, const ALoad& AL, const Epi& E, LAS float* red, int tid) {
    const int lane = tid & 63, wave = tid >> 6, r = lane & 31, h = lane >> 5; const int ks = kl / 8, k0 = kb + wave * ks;
    f32x16 acc;
#pragma unroll
    for (int i = 0; i < 16; ++i) acc[i] = 0.f;
    const bf16_t* wrow = WT + (size_t)(n0 + r) * ldw + k0 + 8 * h;
    for (int k = 0; k < ks; k += 16) { const bf16x8 a = AL(r, k0 + k + 8 * h); const bf16x8 b = *(const bf16x8*)(wrow + k); acc = __builtin_amdgcn_mfma_f32_32x32x16_bf16(a, b, acc, 0, 0, 0); }
#pragma unroll
    for (int i = 0; i < 16; ++i) red[wave * 1024 + i * 64 + lane] = acc[i];
    __syncthreads();
#pragma unroll
    for (int q = 0; q < 2; ++q) { const int e = tid + q * 512; float s = 0.f;
#pragma unroll
        for (int w = 0; w < 8; ++w) s += red[w * 1024 + e];
        const int reg = e >> 6, l = e & 63; E((reg & 3) + 8 * (reg >> 2) + 4 * (l >> 5), n0 + (l & 31), s); }
    __syncthreads();
}
template <class ALoad, class Epi>
__device__ __forceinline__ void sgemm32_item(int n0, int K, const bf16_t* __restrict__ WT, const ALoad& AL, const Epi& E, LAS float* red, int tid) { sgemm32_part(n0, 0, K, K, WT, AL, E, red, tid); }
struct ALoadBf16 { const bf16_t* A; int ld; __device__ __forceinline__ bf16x8 operator()(int row, int k) const { return *(const bf16x8*)(A + (size_t)row * ld + k); } };
struct ALoadF32 { const float* A; int ld;
    __device__ __forceinline__ bf16x8 operator()(int row, int k) const { const f32x4 a = *(const f32x4*)(A + (size_t)row * ld + k), b = *(const f32x4*)(A + (size_t)row * ld + k + 4);
        u32x4 o; o.x = pkbf(a.x, a.y); o.y = pkbf(a.z, a.w); o.z = pkbf(b.x, b.y); o.w = pkbf(b.z, b.w); return __builtin_bit_cast(bf16x8, o); } };

struct EpiIn {
    static constexpr bool PERM = true, AFTER_DRAIN = false;
    bf16_t *PRE, *Z, *QA, *KA, *VA; float* out;
    __device__ __forceinline__ void operator()(const f32x4 (&acc)[2][2][4][2], const pg8::Unit& u, int wr, int wc, int fr, int fq) const {
        const int pn = u.pn, pm = u.pm;
        bf16_t* base; int ldc, coff; float sc = 1.f;
        if (pn < 6) { base = PRE; ldc = CONV_CH; coff = pn * 256; }
        else if (pn < 8) { base = Z; ldc = 512; coff = (pn - 6) * 256; }
        else if (pn < 10) { base = QA; ldc = 512; coff = (pn - 8) * 256; sc = QSCALE; }
        else if (pn < 12) { base = KA; ldc = 512; coff = (pn - 10) * 256; }
        else { base = VA; ldc = 512; coff = (pn - 12) * 256; }
        const int row0 = pm * 256 + wr * 64 + fr, col0 = coff + wc * 32 + 8 * fq;
#pragma unroll
        for (int ai = 0; ai < 2; ++ai)
#pragma unroll
            for (int m = 0; m < 4; ++m) { bf16_t* rowp = base + (size_t)(row0 + ai * 128 + m * 16) * ldc + col0;
#pragma unroll
                for (int bj = 0; bj < 2; ++bj) { const f32x4 v0 = acc[ai][bj][m][0] * sc, v1 = acc[ai][bj][m][1] * sc;
                    u32x4 w; w.x = pkbf(v0[0], v0[1]); w.y = pkbf(v0[2], v0[3]); w.z = pkbf(v1[0], v1[1]); w.w = pkbf(v1[2], v1[3]);
                    *(u32x4*)(rowp + bj * 128) = w; } }
        if (pn >= 10 && (pm & 15) >= 8) {
            float* o = out + (pn < 12 ? O_PWK : O_PWV) + (size_t)((pm >> 4) * WIN + ((pm & 15) - 8) * 256 + wr * 64 + fr) * ATW + col0;
#pragma unroll
            for (int ai = 0; ai < 2; ++ai)
#pragma unroll
                for (int m = 0; m < 4; ++m)
#pragma unroll
                    for (int bj = 0; bj < 2; ++bj) { float* p = o + (size_t)(ai * 128 + m * 16) * ATW + bj * 128; *(f32x4*)p = acc[ai][bj][m][0]; *(f32x4*)(p + 4) = acc[ai][bj][m][1]; }
        }
        if (pn < 6 && (pm & 15) == 15 && wr == 1 && fr >= 13) {
            float* o = out + O_PCONV + (size_t)((pm >> 4) * 3 + (fr - 13)) * CONV_CH + col0;
#pragma unroll
            for (int bj = 0; bj < 2; ++bj) { *(f32x4*)(o + bj * 128) = acc[1][bj][3][0]; *(f32x4*)(o + bj * 128 + 4) = acc[1][bj][3][1]; }
        }
    }
};
__device__ __forceinline__ void p1_inproj(Ctx& C) {
    pg8::Gemm g{WSP(bf16_t, WS_XN), WSP(bf16_t, WS_WIN), M, NIN, D}; pg8::StaticOrder S; S.init(M, NIN, C.G, C.bid);
    EpiIn E{WSP(bf16_t, WS_PRE), WSP(bf16_t, WS_Z), WSP(bf16_t, WS_QA), WSP(bf16_t, WS_KA), WSP(bf16_t, WS_VA), C.out};
    pg8::gemm_phase<EpiIn, pg8::StaticOrder, true, true>(C.lds, g, S, E);
    float* SPROJ = WSP(float, WS_SPROJ);
    const ALoadBf16 AL{WSP(bf16_t, WS_XSN), D};
    auto Ep = [SPROJ](int row, int col, float v) { SPROJ[row * NIN + col] = v; };
    for (int it = C.bid; it < NIN / 32; it += C.G) sgemm32_item(it * 32, D, WSP(bf16_t, WS_WIN), AL, Ep, (LAS float*)C.lds, C.tid);
}

typedef short v4i16_t __attribute__((ext_vector_type(4)));
__device__ __forceinline__ s16x4 tr16(const LAS unsigned char* p) { return __builtin_bit_cast(s16x4, __builtin_amdgcn_ds_read_tr16_b64_v4i16((LAS v4i16_t*)p)); }
typedef float f32x4_t __attribute__((ext_vector_type(4)));

struct AttnItem { int n, h, g, d, rho, B; };
__device__ __forceinline__ AttnItem attn_decode(int item) {
    AttnItem a; const int nh = item / 96, j = item % 96; a.n = nh >> 3; a.h = nh & 7;
    if (j < 32) { a.g = 0; a.d = 1; a.rho = 0; a.B = j; } else if (j < 64) { a.g = 1; a.d = 4; a.rho = (j - 32) >> 3; a.B = (j - 32) & 7; } else { a.g = 2; a.d = 16; a.rho = (j - 64) >> 1; a.B = (j - 64) & 1; }
    return a;
}
struct AttnPre { u32x4 k[4], v[4]; bf16x8 q0, q1; };
__device__ __forceinline__ void attn_prefetch(Ctx& C, const AttnItem& a, AttnPre& P) {
    const bf16_t* QA = WSP(bf16_t, WS_QA); const bf16_t* KA = WSP(bf16_t, WS_KA); const bf16_t* VA = WSP(bf16_t, WS_VA);
    const size_t seq0 = (size_t)a.n * SEQ;
#pragma unroll
    for (int q = 0; q < 4; ++q) { const int ci = C.tid + 512 * q, kl = ci >> 3, c = ci & 7; int sub = 128 * (a.B - 1) + kl; sub = sub < 0 ? 0 : sub;
        const size_t src = (seq0 + a.rho + (size_t)a.d * sub) * 512 + a.h * 64 + c * 8;
        P.k[q] = *(const u32x4*)(KA + src); P.v[q] = *(const u32x4*)(VA + src); }
    const int i = C.lane & 15, G = C.lane >> 4;
    const size_t qrow = seq0 + a.rho + (size_t)a.d * (128 * a.B + 16 * C.wave + i);
    P.q0 = *(const bf16x8*)(QA + qrow * 512 + a.h * 64 + 8 * G); P.q1 = *(const bf16x8*)(QA + qrow * 512 + a.h * 64 + 32 + 8 * G);
}
__device__ __forceinline__ void attn_stage(LAS unsigned char* buf, const AttnPre& P, int tid) {
#pragma unroll
    for (int q = 0; q < 4; ++q) { const int ci = tid + 512 * q, kl = ci >> 3, c = ci & 7;
        *(LAS u32x4*)(buf + kl * 128 + 16 * (c ^ ((kl >> 1) & 7))) = P.k[q];
        *(LAS u32x4*)(buf + 32768 + kl * 128 + 16 * (c ^ (((kl >> 1) & 3) << 1))) = P.v[q]; }
}
__device__ __forceinline__ void attn_compute(Ctx& C, const AttnItem& a, const LAS unsigned char* buf, const bf16x8 qf0, const bf16x8 qf1) {
    bf16_t* OG = WSP(bf16_t, a.g == 0 ? WS_O1 : (a.g == 1 ? WS_O2 : WS_O3)); float* LSE = WSP(float, WS_LSE) + (size_t)a.g * M * 8;
    const int lane = C.lane, w = C.wave, i = lane & 15, G = lane >> 4;
    const LAS unsigned char* Ks = buf; const LAS unsigned char* Vs = buf + 32768;
    const size_t qrow = (size_t)a.n * SEQ + a.rho + (size_t)a.d * (128 * a.B + 16 * w + i);
    const float slope2 = exp2f(-(float)(a.h + 1)) * (float)a.d * LOG2E;
    float be[4];
#pragma unroll
    for (int e = 0; e < 4; ++e) be[e] = -slope2 * (float)(i - 4 * G - e);
    f32x4_t sc[9];
#pragma unroll
    for (int t = 0; t < 9; ++t) { const int kl = 16 * (w + t) + i; const int sw = (kl >> 1) & 7;
        const bf16x8 k0 = *(const LAS bf16x8*)(Ks + kl * 128 + 16 * (G ^ sw)), k1 = *(const LAS bf16x8*)(Ks + kl * 128 + 16 * ((4 + G) ^ sw));
        const float toff = -slope2 * (float)(128 - 16 * t);
        f32x4_t acc = {be[0] + toff, be[1] + toff, be[2] + toff, be[3] + toff};
        acc = __builtin_amdgcn_mfma_f32_16x16x32_bf16(k0, qf0, acc, 0, 0, 0);
        acc = __builtin_amdgcn_mfma_f32_16x16x32_bf16(k1, qf1, acc, 0, 0, 0);
        sc[t] = acc; }
#pragma unroll
    for (int e = 0; e < 4; ++e) { if (4 * G + e < i) sc[0][e] = -INFINITY; if (4 * G + e > i) sc[8][e] = -INFINITY; }
    if (a.B == 0) {
#pragma unroll
        for (int t = 0; t < 8; ++t) if (w + t < 8) sc[t] = (f32x4_t){-INFINITY, -INFINITY, -INFINITY, -INFINITY};
    }
    float mx = -INFINITY;
#pragma unroll
    for (int t = 0; t < 9; ++t) mx = fmaxf(fmaxf(mx, fmaxf(sc[t][0], sc[t][1])), fmaxf(sc[t][2], sc[t][3]));
    mx = fmaxf(mx, __shfl_xor(mx, 16)); mx = fmaxf(mx, __shfl_xor(mx, 32));
    float lsum = 0.f;
#pragma unroll
    for (int t = 0; t < 9; ++t)
#pragma unroll
        for (int e = 0; e < 4; ++e) { const float p = __builtin_amdgcn_exp2f(sc[t][e] - mx); sc[t][e] = p; lsum += p; }
    lsum += __shfl_xor(lsum, 16); lsum += __shfl_xor(lsum, 32);
    f32x4_t o[4];
#pragma unroll
    for (int dt = 0; dt < 4; ++dt) o[dt] = (f32x4_t){0.f, 0.f, 0.f, 0.f};
    const int q4 = (lane & 15) >> 2, p4 = lane & 3;
#pragma unroll
    for (int pp = 0; pp < 5; ++pp) { const int t0 = 2 * pp, t1 = (pp < 4) ? 2 * pp + 1 : 8;
        u32x4 pb; pb.x = pkbf(sc[t0][0], sc[t0][1]); pb.y = pkbf(sc[t0][2], sc[t0][3]);
        if (pp < 4) { pb.z = pkbf(sc[t1][0], sc[t1][1]); pb.w = pkbf(sc[t1][2], sc[t1][3]); } else { pb.z = 0u; pb.w = 0u; }
        const int r0 = 16 * (w + t0) + 4 * G + q4, r1 = 16 * (w + t1) + 4 * G + q4;
        const int s0 = ((r0 >> 1) & 3) << 1, s1 = ((r1 >> 1) & 3) << 1;
#pragma unroll
        for (int dt = 0; dt < 4; ++dt) { const int c = 2 * dt + (p4 >> 1);
            const s16x4 lo = tr16(Vs + r0 * 128 + 16 * (c ^ s0) + 8 * (p4 & 1)), hi = tr16(Vs + r1 * 128 + 16 * (c ^ s1) + 8 * (p4 & 1));
            const bf16x8 vf = {lo[0], lo[1], lo[2], lo[3], hi[0], hi[1], hi[2], hi[3]};
            o[dt] = __builtin_amdgcn_mfma_f32_16x16x32_bf16(vf, __builtin_bit_cast(bf16x8, pb), o[dt], 0, 0, 0); } }
    const float inv = __builtin_amdgcn_rcpf(lsum);
#pragma unroll
    for (int dt = 0; dt < 4; ++dt) { u32x2 ov; ov.x = pkbf(o[dt][0] * inv, o[dt][1] * inv); ov.y = pkbf(o[dt][2] * inv, o[dt][3] * inv);
        *(u32x2*)(OG + qrow * 512 + a.h * 64 + 16 * dt + 4 * G) = ov; }
    if (G == 0) LSE[qrow * 8 + a.h] = mx + __builtin_amdgcn_logf(lsum);
}
__device__ __forceinline__ void attn_phase(Ctx& C, int n_items, int first, int stride) {
    int it = first; if (it >= n_items) return;
    AttnPre P; AttnItem cur = attn_decode(it);
    attn_prefetch(C, cur, P);
    int par = 0;
    for (;;) {
        LAS unsigned char* buf = C.lds + par * 65536;
        attn_stage(buf, P, C.tid);
        const bf16x8 qf0 = P.q0, qf1 = P.q1;
        __syncthreads();
        const int nit = it + stride; AttnItem nxt = cur;
        if (nit < n_items) { nxt = attn_decode(nit); attn_prefetch(C, nxt, P); }
        attn_compute(C, cur, buf, qf0, qf1);
        if (nit >= n_items) break;
        it = nit; cur = nxt; par ^= 1;
    }
    __syncthreads();
}

__device__ __forceinline__ void smp_delta_item(Ctx& C, int item) {
    const int b = item >> 2, hd = item & 3, tid = C.tid;
    const float* SPROJ = WSP(float, WS_SPROJ) + (size_t)b * NIN; const float* SG = WSP(float, WS_SGATE) + b * 8;
    LAS float* L = (LAS float*)C.lds;
    LAS float* yq = L; LAS float* yk = L + 128; LAS float* yv = L + 256; LAS float* red = L + 384; LAS float* pk = L + 512; LAS float* pq = L + 1024; LAS float* ob = L + 1536;
    if (tid < 384) { const int which = tid >> 7, c = tid & 127; const int ch = which * 512 + hd * 128 + c;
        const float s0 = C.st_conv[((size_t)b * 3 + 0) * CONV_CH + ch], s1 = C.st_conv[((size_t)b * 3 + 1) * CONV_CH + ch], s2 = C.st_conv[((size_t)b * 3 + 2) * CONV_CH + ch], xn = SPROJ[ch];
        const float y = s0 * C.conv_w[ch] + s1 * C.conv_w[CONV_CH + ch] + s2 * C.conv_w[2 * CONV_CH + ch] + xn * C.conv_w[3 * CONV_CH + ch];
        L[tid] = siluf(y);
        float* sc = C.out + O_SCONV + (size_t)b * 3 * CONV_CH; sc[ch] = s1; sc[CONV_CH + ch] = s2; sc[2 * CONV_CH + ch] = xn; }
    __syncthreads();
    if (tid < 192) { const int wv = tid >> 6, lane = tid & 63;
        const float a0 = (wv == 1 ? yk : yq)[lane], a1 = (wv == 1 ? yk : yq)[lane + 64], b0 = (wv == 0 ? yq : yk)[lane], b1 = (wv == 0 ? yq : yk)[lane + 64];
        const float s = wave_sum(a0 * b0 + a1 * b1); if (lane == 0) red[wv] = s; }
    __syncthreads();
    const float rq = rsqrtf(red[0] + EPS) * 0.08838834764831845f, rk = rsqrtf(red[1] + EPS);
    const float qk = red[2] * rq * rk;
    const float beta = SG[hd], gdec = __expf(SG[4 + hd]);
    const int v = tid & 127, kq = tid >> 7;
    const float* S0 = C.st_ssm + ((size_t)(b * 4 + hd) * DK + 32 * kq) * DV + v;
    float sreg[32]; float aks = 0.f, aqs = 0.f;
#pragma unroll
    for (int k = 0; k < 32; ++k) { sreg[k] = S0[(size_t)k * DV]; aks += yk[32 * kq + k] * sreg[k]; aqs += yq[32 * kq + k] * sreg[k]; }
    pk[kq * 128 + v] = aks; pq[kq * 128 + v] = aqs;
    __syncthreads();
    const float kS = ((pk[v] + pk[128 + v]) + (pk[256 + v] + pk[384 + v])) * rk, qS = ((pq[v] + pq[128 + v]) + (pq[256 + v] + pq[384 + v])) * rq;
    const float vnew = beta * (yv[v] - gdec * kS);
    const float o = gdec * qS + qk * vnew;
    float* S1 = C.out + O_SSSM + ((size_t)(b * 4 + hd) * DK + 32 * kq) * DV + v;
#pragma unroll
    for (int k = 0; k < 32; ++k) S1[(size_t)k * DV] = gdec * sreg[k] + (yk[32 * kq + k] * rk) * vnew;
    if (kq == 0) ob[v] = o;
    __syncthreads();
    if (tid < 64) { const float s = wave_sum(ob[tid] * ob[tid] + ob[tid + 64] * ob[tid + 64]); if (tid == 0) red[4] = s; }
    __syncthreads();
    if (tid < 128) { const float rs = rsqrtf(red[4] * (1.f / DV) + EPS); const float z = SPROJ[CONV_CH + hd * 128 + tid];
        const float r = ob[tid] * rs * C.dn_norm[tid] * siluf(z);
        WSP(bf16_t, WS_SMIX)[(size_t)b * D + hd * 128 + tid] = (bf16_t)(pkbf(r, 0.f) & 0xffffu); }
    __syncthreads();
}

__device__ __forceinline__ void smp_attn_task(Ctx& C, int task) {
    const int half = task & 1, g = (task >> 1) % 3, bh = task / 6, b = bh >> 3, h = bh & 7, lane = C.lane;
    const int dil = g == 0 ? 1 : (g == 1 ? 4 : 16), r = 1 + 64 * half + lane;
    const float* q = WSP(float, WS_SPROJ) + (size_t)b * NIN + 2048 + h * 64;
    const size_t off = (((size_t)b * WIN + (WIN - r * dil)) * ATH + h) * ATD;
    f32x4 kv[16], vv[16];
#pragma unroll
    for (int i = 0; i < 16; ++i) kv[i] = ((const f32x4*)(C.ck + off))[i];
#pragma unroll
    for (int i = 0; i < 16; ++i) vv[i] = ((const f32x4*)(C.cv + off))[i];
    float s = 0.f;
#pragma unroll
    for (int i = 0; i < 16; ++i) { const f32x4 qq = ((const f32x4*)q)[i]; s += (qq.x * kv[i].x + qq.y * kv[i].y) + (qq.z * kv[i].z + qq.w * kv[i].w); }
    s = s * QSCALE - exp2f(-(float)(h + 1)) * LOG2E * (float)(r * dil);
    float m = s;
#pragma unroll
    for (int o = 1; o < 64; o <<= 1) m = fmaxf(m, __shfl_xor(m, o));
    const float p = exp2f(s - m); const float l = wave_sum(p);
    float a[64];
#pragma unroll
    for (int i = 0; i < 16; ++i) { a[4 * i] = p * vv[i].x; a[4 * i + 1] = p * vv[i].y; a[4 * i + 2] = p * vv[i].z; a[4 * i + 3] = p * vv[i].w; }
#define TRED(W, BIT) { const bool hi_ = (lane & BIT) != 0; _Pragma("unroll") for (int i = 0; i < W; ++i) { const float keep = hi_ ? a[i + W] : a[i], send = hi_ ? a[i] : a[i + W]; a[i] = keep + __shfl_xor(send, BIT); } }
    TRED(32, 32) TRED(16, 16) TRED(8, 8) TRED(4, 4) TRED(2, 2) TRED(1, 1)
#undef TRED
    float* P = WSP(float, WS_SATT) + (size_t)task * 66;
    P[2 + lane] = a[0];
    if (lane == 0) { P[0] = m; P[1] = l; }
}
__device__ __forceinline__ void smp_attn_merge(Ctx& C, int bh) {
    const int b = bh >> 3, h = bh & 7, lane = C.lane;
    const float* SPROJ = WSP(float, WS_SPROJ) + (size_t)b * NIN;
    const float s0 = wave_sum(SPROJ[2048 + h * 64 + lane] * SPROJ[2560 + h * 64 + lane]) * QSCALE;
    const float* P = WSP(float, WS_SATT) + (size_t)bh * 6 * 66;
    float mx = s0;
#pragma unroll
    for (int t = 0; t < 6; ++t) mx = fmaxf(mx, P[t * 66]);
    const float w0 = 3.f * exp2f(s0 - mx);
    float l = w0, o = w0 * SPROJ[3072 + h * 64 + lane];
#pragma unroll
    for (int t = 0; t < 6; ++t) { const float w = exp2f(P[t * 66] - mx); l += w * P[t * 66 + 1]; o += w * P[t * 66 + 2 + lane]; }
    WSP(bf16_t, WS_SMIX)[(size_t)b * D + 512 + h * 64 + lane] = (bf16_t)(pkbf(o / l, 0.f) & 0xffffu);
}

__device__ __forceinline__ void smp_window_copy(Ctx& C, int part, int nparts) {
    const float* SPROJ = WSP(float, WS_SPROJ);
    const size_t total = (size_t)2 * SB * WIN * 128;
    for (size_t blk = (size_t)part * (8 * NTHREADS); blk < total; blk += (size_t)nparts * (8 * NTHREADS)) {
        f32x4 val[8];
#pragma unroll
        for (int u = 0; u < 8; ++u) { const size_t idx = blk + u * NTHREADS + C.tid;
            const int c4 = (int)(idx & 127); const size_t rowi = idx >> 7; const int jrow = (int)(rowi & (WIN - 1)); const int b = (int)((rowi >> 11) & 31); const int kv = (int)(rowi >> 16);
            if (jrow < WIN - 1) val[u] = __builtin_nontemporal_load((const f32x4*)(kv ? C.cv : C.ck) + ((size_t)b * WIN + jrow + 1) * 128 + c4);
            else val[u] = *(const f32x4*)(SPROJ + (size_t)b * NIN + (kv ? 3072 : 2560) + 4 * c4); }
#pragma unroll
        for (int u = 0; u < 8; ++u) { const size_t idx = blk + u * NTHREADS + C.tid;
            const int c4 = (int)(idx & 127); const size_t rowi = idx >> 7; const int jrow = (int)(rowi & (WIN - 1)); const int b = (int)((rowi >> 11) & 31); const int kv = (int)(rowi >> 16);
            __builtin_nontemporal_store(val[u], (f32x4*)(C.out + (kv ? O_SWV : O_SWK)) + ((size_t)b * WIN + jrow) * 128 + c4); }
    }
}

constexpr int PL_KN = 0, PL_VV = 33792, PL_QB = 67584, PL_MM = 84992, PL_WB = 102400, PL_SM = 119808, PL_TD = 121856;
__device__ __forceinline__ LAS unsigned char* opaque_lds(LAS unsigned char* p) { unsigned v = (unsigned)(uintptr_t)p; asm volatile("" : "+v"(v)); return (LAS unsigned char*)(uintptr_t)v; }
__device__ __forceinline__ bf16x8 ld_f32x8_as_bf16(const LAS float* p) { const f32x4 a = *(const LAS f32x4*)p, b = *(const LAS f32x4*)(p + 4);
    u32x4 o; o.x = pkbf(a.x, a.y); o.y = pkbf(a.z, a.w); o.z = pkbf(b.x, b.y); o.w = pkbf(b.z, b.w); return __builtin_bit_cast(bf16x8, o); }

struct PrepPre { u32x4 r[11]; float be, g; };
__device__ __forceinline__ void prep_prefetch(Ctx& C, int item, PrepPre& P) {
    const int c = item & 63, hd = (item >> 6) & 3, n = item >> 8, tid = C.tid; const size_t seq0 = (size_t)n * SEQ;
    if (tid < 384) { const int cg = tid % 48, seg = tid / 48, which = cg >> 4, c8 = cg & 15; const int chb = which * 512 + hd * 128 + 8 * c8;
        const bf16_t* PRE = WSP(bf16_t, WS_PRE);
#pragma unroll
        for (int rr = 0; rr < 11; ++rr) { const int t = 64 * c + 8 * seg + rr - 3; u32x4 v = {0u, 0u, 0u, 0u};
            if (t >= 0) v = *(const u32x4*)(PRE + (seq0 + t) * CONV_CH + chb);
            P.r[rr] = v; }
    } else if (C.wave == 6) { const size_t row = seq0 + 64 * c + C.lane; P.be = WSP(float, WS_BETA)[row * 4 + hd]; P.g = WSP(float, WS_GG)[row * 4 + hd]; }
}
__device__ __forceinline__ void gdn_prep_item(Ctx& C, int item, PrepPre& P, int next_item) {
    const int c = item & 63, hd = (item >> 6) & 3, n = item >> 8;
    const int tid = C.tid, lane = C.lane, wave = C.wave;
    const size_t seq0 = (size_t)n * SEQ;
    LAS unsigned char* L0 = opaque_lds(C.lds);
    LAS float* KN = (LAS float*)(L0 + PL_KN); LAS float* VV = (LAS float*)(L0 + PL_VV); LAS bf16_t* QB = (LAS bf16_t*)(L0 + PL_QB);
    LAS float* MM = (LAS float*)(L0 + PL_MM); LAS bf16_t* WB = (LAS bf16_t*)(L0 + PL_WB); LAS float* SM = (LAS float*)(L0 + PL_SM);
    LAS float* s_beta = SM; LAS float* s_gc = SM + 64; LAS float* s_egc = SM + 128; LAS float* s_ekd = SM + 192; LAS float* s_bw = SM + 256; LAS float* TD = (LAS float*)(L0 + PL_TD);
    unsigned char* img = C.ws + WS_GDN + (size_t)item * GDN_CHUNK_BYTES;
    if (tid < 384) {
        const int cg = tid % 48, seg = tid / 48, which = cg >> 4, c8 = cg & 15; const int chb = which * 512 + hd * 128 + 8 * c8;
        float cw[4][8];
#pragma unroll
        for (int i = 0; i < 4; ++i) { const f32x4 a = *(const f32x4*)(C.conv_w + i * CONV_CH + chb), b = *(const f32x4*)(C.conv_w + i * CONV_CH + chb + 4);
            cw[i][0] = a.x; cw[i][1] = a.y; cw[i][2] = a.z; cw[i][3] = a.w; cw[i][4] = b.x; cw[i][5] = b.y; cw[i][6] = b.z; cw[i][7] = b.w; }
        float xr[11][8];
#pragma unroll
        for (int rr = 0; rr < 11; ++rr) { const u32x4 v = P.r[rr];
            xr[rr][0] = bflo(v.x); xr[rr][1] = bfhi(v.x); xr[rr][2] = bflo(v.y); xr[rr][3] = bfhi(v.y); xr[rr][4] = bflo(v.z); xr[rr][5] = bfhi(v.z); xr[rr][6] = bflo(v.w); xr[rr][7] = bfhi(v.w); }
#pragma unroll
        for (int tt = 0; tt < 8; ++tt) { float y[8]; float ss = 0.f;
#pragma unroll
            for (int e = 0; e < 8; ++e) { const float a = (xr[tt][e] * cw[0][e] + xr[tt + 1][e] * cw[1][e]) + (xr[tt + 2][e] * cw[2][e] + xr[tt + 3][e] * cw[3][e]); y[e] = siluf(a); ss += y[e] * y[e]; }
            ss += __shfl_xor(ss, 1); ss += __shfl_xor(ss, 2); ss += __shfl_xor(ss, 4); ss += __shfl_xor(ss, 8);
            const int row = 8 * seg + tt;
            if (which == 0) { const float sc = rsqrtf(ss + EPS) * 0.08838834764831845f;
                u32x4 o; o.x = pkbf(y[0] * sc, y[1] * sc); o.y = pkbf(y[2] * sc, y[3] * sc); o.z = pkbf(y[4] * sc, y[5] * sc); o.w = pkbf(y[6] * sc, y[7] * sc);
                *(LAS u32x4*)(QB + row * 136 + 8 * c8) = o; }
            else { const float sc = which == 1 ? rsqrtf(ss + EPS) : 1.f; LAS float* dst = (which == 1 ? KN : VV) + row * 132 + 8 * c8;
                *(LAS f32x4*)dst = (f32x4){y[0] * sc, y[1] * sc, y[2] * sc, y[3] * sc}; *(LAS f32x4*)(dst + 4) = (f32x4){y[4] * sc, y[5] * sc, y[6] * sc, y[7] * sc}; } }
    } else if (wave == 6) {
        const float be = P.be; float x = P.g;
#pragma unroll
        for (int off = 1; off < 64; off <<= 1) { const float t = __shfl_up(x, off); if (lane >= off) x += t; }
        const float gl = __shfl(x, 63);
        s_beta[lane] = be; s_gc[lane] = x; s_egc[lane] = __expf(x); s_ekd[lane] = __expf(gl - x); s_bw[lane] = be * __expf(x);
        if (lane == 0) WSP(float, WS_EGL)[item] = __expf(gl);
    }
    __syncthreads();
    if (next_item >= 0) prep_prefetch(C, next_item, P);
    if (wave < 6) {
        const int kind = wave / 3, tsel = wave % 3; const int it = tsel == 1 ? 0 : 1, jt = tsel == 2 ? 1 : 0;
        const int r = lane & 31, hh = lane >> 5;
        f32x16 acc;
#pragma unroll
        for (int e = 0; e < 16; ++e) acc[e] = 0.f;
#pragma unroll
        for (int ks = 0; ks < 8; ++ks) { const bf16x8 a = ld_f32x8_as_bf16(KN + (32 * jt + r) * 132 + 16 * ks + 8 * hh);
            bf16x8 b; if (kind == 0) b = ld_f32x8_as_bf16(KN + (32 * it + r) * 132 + 16 * ks + 8 * hh); else b = *(const LAS bf16x8*)(QB + (32 * it + r) * 136 + 16 * ks + 8 * hh);
            acc = __builtin_amdgcn_mfma_f32_32x32x16_bf16(a, b, acc, 0, 0, 0); }
        const int i = 32 * it + r; const float gci = s_gc[i], nbi = -s_beta[i];
        float vals[16];
#pragma unroll
        for (int e = 0; e < 16; ++e) { const int j = 32 * jt + (e & 3) + 8 * (e >> 2) + 4 * hh; const float dec = __expf(gci - s_gc[j]);
            vals[e] = kind == 0 ? ((i > j) ? nbi * acc[e] * dec : 0.f) : ((i >= j) ? acc[e] * dec : 0.f); }
        if (kind == 0) {
#pragma unroll
            for (int a4 = 0; a4 < 4; ++a4) *(LAS f32x4*)(MM + i * 68 + 32 * jt + 8 * a4 + 4 * hh) = (f32x4){vals[4 * a4], vals[4 * a4 + 1], vals[4 * a4 + 2], vals[4 * a4 + 3]};
        } else {
#pragma unroll
            for (int s = 0; s < 2; ++s) { u32x4 o; o.x = pkbf(vals[8 * s], vals[8 * s + 1]); o.y = pkbf(vals[8 * s + 2], vals[8 * s + 3]); o.z = pkbf(vals[8 * s + 4], vals[8 * s + 5]); o.w = pkbf(vals[8 * s + 6], vals[8 * s + 7]);
                *(u32x4*)(img + GI_QK + ((it * 4 + 2 * jt + s) * 64 + lane) * 16) = o; }
        }
    } else {
        const int t2 = tid - 384;
#pragma unroll
        for (int q = 0; q < 8; ++q) { const int f = t2 + 128 * q; const int lf = f & 63, kk = (f >> 6) & 7, rt = f >> 9; const int r = lf & 31, hh = lf >> 5;
            const int i = 32 * rt + r, cb = 32 * (kk >> 1) + 16 * (kk & 1) + 4 * hh; const float e = s_egc[i];
            const u32x2 a = *(const LAS u32x2*)(QB + i * 136 + cb), b = *(const LAS u32x2*)(QB + i * 136 + cb + 8);
            u32x4 o; o.x = pkbf(bflo(a.x) * e, bfhi(a.x) * e); o.y = pkbf(bflo(a.y) * e, bfhi(a.y) * e); o.z = pkbf(bflo(b.x) * e, bfhi(b.x) * e); o.w = pkbf(bflo(b.y) * e, bfhi(b.y) * e);
            *(u32x4*)(img + GI_QG + f * 16) = o; }
    }
    __syncthreads();
    if (wave == 0) {
        const int d = lane >> 4, j = lane & 15; const LAS float* Md = MM + (16 * d) * 68 + 16 * d; float t[16];
#pragma unroll
        for (int i = 0; i < 16; ++i) { float a = (i == j) ? 1.f : 0.f;
#pragma unroll
            for (int k = 0; k < i; ++k) a += Md[i * 68 + k] * t[k];
            t[i] = a; TD[(d * 16 + i) * 16 + j] = a; }
    } else if (wave >= 4) {
        const int t2 = tid - 256;
#pragma unroll
        for (int q = 0; q < 4; ++q) { const int f = t2 + 256 * q; const int lf = f & 63, kk = (f >> 6) & 3, rt = f >> 8; const int r = lf & 31, hh = lf >> 5;
            const int cc = 32 * rt + r, tb = 32 * (kk >> 1) + 16 * (kk & 1) + 4 * hh; float v[8];
#pragma unroll
            for (int jj = 0; jj < 8; ++jj) { const int tk = tb + 8 * (jj >> 2) + (jj & 3); v[jj] = KN[tk * 132 + cc] * s_ekd[tk]; }
            u32x4 o; o.x = pkbf(v[0], v[1]); o.y = pkbf(v[2], v[3]); o.z = pkbf(v[4], v[5]); o.w = pkbf(v[6], v[7]);
            *(u32x4*)(img + GI_KD + f * 16) = o; }
    }
    __syncthreads();
    {
        const int i16 = lane & 15, G = lane >> 4; const bool isw = wave >= 4;
        const LAS float* src = (isw ? KN : VV) + 32 * (wave & 3) + i16; const LAS float* scl = isw ? s_bw : s_beta;
        f32x4 X[4][2];
#pragma unroll
        for (int bi = 0; bi < 4; ++bi) {
#pragma unroll
            for (int tl = 0; tl < 2; ++tl)
#pragma unroll
                for (int e = 0; e < 4; ++e) { const int row = 16 * bi + 4 * G + e; X[bi][tl][e] = scl[row] * src[row * 132 + 16 * tl]; }
#pragma unroll
            for (int bj = 0; bj < bi; ++bj) { const f32x4 a = *(const LAS f32x4*)(MM + (16 * bi + i16) * 68 + 16 * bj + 4 * G);
#pragma unroll
                for (int s4 = 0; s4 < 4; ++s4)
#pragma unroll
                    for (int tl = 0; tl < 2; ++tl) X[bi][tl] = __builtin_amdgcn_mfma_f32_16x16x4f32(a[s4], X[bj][tl][s4], X[bi][tl], 0, 0, 0); }
            const f32x4 td = *(const LAS f32x4*)(TD + (bi * 16 + i16) * 16 + 4 * G);
            f32x4 y0 = {0.f, 0.f, 0.f, 0.f}, y1 = {0.f, 0.f, 0.f, 0.f};
#pragma unroll
            for (int s4 = 0; s4 < 4; ++s4) { y0 = __builtin_amdgcn_mfma_f32_16x16x4f32(td[s4], X[bi][0][s4], y0, 0, 0, 0); y1 = __builtin_amdgcn_mfma_f32_16x16x4f32(td[s4], X[bi][1][s4], y1, 0, 0, 0); }
            X[bi][0] = y0; X[bi][1] = y1;
        }
        if (!isw) {
#pragma unroll
            for (int bi = 0; bi < 4; ++bi)
#pragma unroll
                for (int tl = 0; tl < 2; ++tl) { u32x2 o; o.x = pkbf(X[bi][tl][0], X[bi][tl][1]); o.y = pkbf(X[bi][tl][2], X[bi][tl][3]);
                    *(u32x2*)(img + GI_U + (((wave * 2 + (bi >> 1)) * 64) + 32 * (G & 1) + 16 * tl + i16) * 32 + 8 * (2 * (bi & 1) + (G >> 1))) = o; }
        } else {
#pragma unroll
            for (int bi = 0; bi < 4; ++bi)
#pragma unroll
                for (int tl = 0; tl < 2; ++tl)
#pragma unroll
                    for (int e = 0; e < 4; ++e) WB[(16 * bi + 4 * G + e) * 136 + 32 * (wave - 4) + 16 * tl + i16] = (bf16_t)(pkbf(-X[bi][tl][e], 0.f) & 0xffffu);
        }
    }
    __syncthreads();
#pragma unroll
    for (int q = 0; q < 2; ++q) { const int f = tid + 512 * q; const int lf = f & 63, kk = (f >> 6) & 7, rt = f >> 9; const int r = lf & 31, hh = lf >> 5;
        const int i = 32 * rt + r, cb = 32 * (kk >> 1) + 16 * (kk & 1) + 4 * hh;
        const u32x2 a = *(const LAS u32x2*)(WB + i * 136 + cb), b = *(const LAS u32x2*)(WB + i * 136 + cb + 8);
        *(u32x4*)(img + GI_NW + f * 16) = (u32x4){a.x, a.y, b.x, b.y}; }
}

constexpr int SC_BUF = 57344;
__device__ __forceinline__ bf16x8 pack8(const f32x16& a, int s) {
    u32x4 o; o.x = pkbf(a[8 * s + 0], a[8 * s + 1]); o.y = pkbf(a[8 * s + 2], a[8 * s + 3]); o.z = pkbf(a[8 * s + 4], a[8 * s + 5]); o.w = pkbf(a[8 * s + 6], a[8 * s + 7]); return __builtin_bit_cast(bf16x8, o); }
constexpr int SC_SLOTA = 32768, SC_SLOTB = 38912, SC_B0 = 2 * SC_SLOTA, SC_STG = SC_B0 + 2 * SC_SLOTB, SC_END = SC_STG + 16384;
__device__ __forceinline__ void gdn_scan_item(Ctx& C, int item) {
    const int n = item >> 2, hd = item & 3, lane = C.lane, wave = C.wave, w4 = wave - 4;
    const unsigned char* base = C.ws + WS_GDN + (size_t)item * 64 * GDN_CHUNK_BYTES;
    const float* EGL = WSP(float, WS_EGL) + item * 64;
    bf16_t* ORAW = WSP(bf16_t, WS_ORAW);
    LAS unsigned char* L0 = opaque_lds(C.lds);
#define SC_BAR() do { asm volatile("s_waitcnt lgkmcnt(0)" ::: "memory"); __builtin_amdgcn_s_barrier(); asm volatile("" ::: "memory"); } while (0)
#define SC_PIN() __builtin_amdgcn_sched_barrier(0)
    if (wave < 4) {
      f32x16 S[4];
#pragma unroll
      for (int a = 0; a < 4; ++a) {
#pragma unroll
        for (int e = 0; e < 16; ++e) S[a][e] = 0.f; }
      const unsigned eglv = __float_as_uint(EGL[lane]);
      SC_BAR();
      for (int c = 0; c < NCH; ++c) {
        int ln = lane; asm volatile("" : "+v"(ln));
        const int lr = ln & 31, lh = ln >> 5;
        const LAS unsigned char* sa = L0 + (c & 1) * SC_SLOTA; const LAS unsigned char* sbp = L0 + SC_B0 + (c & 1) * SC_SLOTB;
        const LAS unsigned char* fNW = sa + ln * 16; const LAS unsigned char* fU = sa + 16384 + ((wave * 2) * 64 + ln) * 32;
        const LAS unsigned char* fQG = sbp + ln * 16; const LAS unsigned char* fQK = sbp + 16384 + ln * 16; const LAS unsigned char* fKD = sbp + 22528 + ln * 16;
        bf16x8 G0[8], G1[8];
#define SC_RD(G, ptr, i0) do { _Pragma("unroll") for (int i_ = 0; i_ < 8; ++i_) G[i_] = *(const LAS bf16x8*)((ptr) + ((i0) + i_) * 1024); } while (0)
#define SC_RD_H(G, ptr, h) do { _Pragma("unroll") for (int i_ = 0; i_ < 4; ++i_) { G[i_] = *(const LAS bf16x8*)((ptr) + (4 * (h) + i_) * 1024); G[4 + i_] = *(const LAS bf16x8*)((ptr) + (8 + 4 * (h) + i_) * 1024); } } while (0)
        u32x4 uu[2][2];
#pragma unroll
        for (int rt = 0; rt < 2; ++rt) { uu[rt][0] = *(const LAS u32x4*)(fU + rt * 2048); uu[rt][1] = *(const LAS u32x4*)(fU + rt * 2048 + 16); }
        SC_RD_H(G0, fNW, 0); SC_RD_H(G1, fNW, 1); SC_PIN();
        f32x16 Y[2];
#pragma unroll
        for (int rt = 0; rt < 2; ++rt)
#pragma unroll
            for (int q = 0; q < 2; ++q) { const u32x4 u = uu[rt][q];
                Y[rt][8 * q + 0] = bflo(u.x); Y[rt][8 * q + 1] = bfhi(u.x); Y[rt][8 * q + 2] = bflo(u.y); Y[rt][8 * q + 3] = bfhi(u.y);
                Y[rt][8 * q + 4] = bflo(u.z); Y[rt][8 * q + 5] = bfhi(u.z); Y[rt][8 * q + 6] = bflo(u.w); Y[rt][8 * q + 7] = bfhi(u.w); }
#pragma unroll
        for (int k4 = 0; k4 < 4; ++k4) { const bf16x8 sb = pack8(S[k4 >> 1], k4 & 1);
            Y[0] = __builtin_amdgcn_mfma_f32_32x32x16_bf16(G0[k4], sb, Y[0], 0, 0, 0); Y[1] = __builtin_amdgcn_mfma_f32_32x32x16_bf16(G0[4 + k4], sb, Y[1], 0, 0, 0); }
        SC_PIN(); SC_RD_H(G0, fQG, 0); SC_PIN();
#pragma unroll
        for (int k4 = 0; k4 < 4; ++k4) { const bf16x8 sb = pack8(S[2 + (k4 >> 1)], k4 & 1);
            Y[0] = __builtin_amdgcn_mfma_f32_32x32x16_bf16(G1[k4], sb, Y[0], 0, 0, 0); Y[1] = __builtin_amdgcn_mfma_f32_32x32x16_bf16(G1[4 + k4], sb, Y[1], 0, 0, 0); }
        SC_PIN(); SC_RD_H(G1, fQG, 1); SC_PIN();
        f32x16 O[2];
#pragma unroll
        for (int rt = 0; rt < 2; ++rt)
#pragma unroll
            for (int e = 0; e < 16; ++e) O[rt][e] = 0.f;
#pragma unroll
        for (int k4 = 0; k4 < 4; ++k4) { const bf16x8 sb = pack8(S[k4 >> 1], k4 & 1);
            O[0] = __builtin_amdgcn_mfma_f32_32x32x16_bf16(G0[k4], sb, O[0], 0, 0, 0); O[1] = __builtin_amdgcn_mfma_f32_32x32x16_bf16(G0[4 + k4], sb, O[1], 0, 0, 0); }
        SC_PIN();
#pragma unroll
        for (int i = 0; i < 6; ++i) G0[i] = *(const LAS bf16x8*)(fQK + i * 1024);
        SC_PIN();
#pragma unroll
        for (int k4 = 0; k4 < 4; ++k4) { const bf16x8 sb = pack8(S[2 + (k4 >> 1)], k4 & 1);
            O[0] = __builtin_amdgcn_mfma_f32_32x32x16_bf16(G1[k4], sb, O[0], 0, 0, 0); O[1] = __builtin_amdgcn_mfma_f32_32x32x16_bf16(G1[4 + k4], sb, O[1], 0, 0, 0); }
        SC_PIN(); SC_RD(G1, fKD, 0); SC_PIN();
        bf16x8 Yb[2][2];
#pragma unroll
        for (int yt = 0; yt < 2; ++yt) { Yb[yt][0] = pack8(Y[yt], 0); Yb[yt][1] = pack8(Y[yt], 1); }
        O[0] = __builtin_amdgcn_mfma_f32_32x32x16_bf16(G0[0], Yb[0][0], O[0], 0, 0, 0); O[0] = __builtin_amdgcn_mfma_f32_32x32x16_bf16(G0[1], Yb[0][1], O[0], 0, 0, 0);
#pragma unroll
        for (int kk = 0; kk < 4; ++kk) O[1] = __builtin_amdgcn_mfma_f32_32x32x16_bf16(G0[2 + kk], Yb[kk >> 1][kk & 1], O[1], 0, 0, 0);
        SC_PIN(); SC_RD(G0, fKD, 8); SC_PIN();
        const float egl = __uint_as_float(__builtin_amdgcn_readlane(eglv, c));
#pragma unroll
        for (int a = 0; a < 2; ++a) {
#pragma unroll
            for (int e = 0; e < 16; ++e) S[a][e] *= egl;
#pragma unroll
            for (int kk = 0; kk < 4; ++kk) S[a] = __builtin_amdgcn_mfma_f32_32x32x16_bf16(G1[a * 4 + kk], Yb[kk >> 1][kk & 1], S[a], 0, 0, 0); }
        { LAS bf16_t* stg = (LAS bf16_t*)(L0 + SC_STG) + (4 * lh) * 128 + wave * 32 + lr;
#pragma unroll
          for (int rt = 0; rt < 2; ++rt)
#pragma unroll
            for (int e = 0; e < 16; ++e) stg[(32 * rt + (e & 3) + 8 * (e >> 2)) * 128] = (bf16_t)(pkbf(O[rt][e], 0.f) & 0xffffu); }
        SC_BAR();
#pragma unroll
        for (int a = 2; a < 4; ++a) {
#pragma unroll
            for (int e = 0; e < 16; ++e) S[a][e] *= egl;
#pragma unroll
            for (int kk = 0; kk < 4; ++kk) S[a] = __builtin_amdgcn_mfma_f32_32x32x16_bf16(G0[(a - 2) * 4 + kk], Yb[kk >> 1][kk & 1], S[a], 0, 0, 0); }
        SC_BAR();
#undef SC_RD
#undef SC_RD_H
      }
      { const int r = lane & 31, hh = lane >> 5;
        float* ps = C.out + O_PSSM + ((size_t)item * DK + 4 * hh) * DV + wave * 32 + r;
#pragma unroll
        for (int a = 0; a < 4; ++a)
#pragma unroll
            for (int e = 0; e < 16; ++e) ps[(size_t)(32 * a + (e & 3) + 8 * (e >> 2)) * DV] = S[a][e]; }
    } else {
      u32x4 RA0[8], RB0[10], RA1[8], RB1[10];
#define SC_LD_A(RA, cidx, LN) do { const int cc_ = (cidx) < NCH ? (cidx) : NCH - 1; const unsigned char* g_ = base + (size_t)cc_ * GDN_CHUNK_BYTES + (LN) * 16 + w4 * 1024; \
        _Pragma("unroll") for (int q_ = 0; q_ < 4; ++q_) RA[q_] = *(const u32x4*)(g_ + GI_NW + q_ * 4096); \
        _Pragma("unroll") for (int q_ = 0; q_ < 4; ++q_) RA[4 + q_] = *(const u32x4*)(g_ + GI_U + q_ * 4096); } while (0)
#define SC_LD_B(RB, cidx, LN) do { const int cc_ = (cidx) < NCH ? (cidx) : NCH - 1; const unsigned char* g_ = base + (size_t)cc_ * GDN_CHUNK_BYTES + (LN) * 16 + w4 * 1024; \
        _Pragma("unroll") for (int q_ = 0; q_ < 10; ++q_) RB[q_] = *(const u32x4*)(g_ + GI_QG + q_ * 4096); } while (0)
#define SC_ST_A(RA, slot, LN) do { LAS unsigned char* la_ = L0 + (slot) * SC_SLOTA + w4 * 1024 + (LN) * 16; \
        _Pragma("unroll") for (int q_ = 0; q_ < 4; ++q_) *(LAS u32x4*)(la_ + q_ * 4096) = RA[q_]; \
        _Pragma("unroll") for (int q_ = 0; q_ < 4; ++q_) *(LAS u32x4*)(la_ + 16384 + q_ * 4096) = RA[4 + q_]; } while (0)
#define SC_ST_B(RB, slot, LN) do { LAS unsigned char* lb_ = L0 + SC_B0 + (slot) * SC_SLOTB + w4 * 1024 + (LN) * 16; \
        _Pragma("unroll") for (int q_ = 0; q_ < 10; ++q_) { if (q_ < 4) *(LAS u32x4*)(lb_ + q_ * 4096) = RB[q_]; else if (q_ == 4) { if (w4 < 2) *(LAS u32x4*)(lb_ + q_ * 4096) = RB[q_]; } else *(LAS u32x4*)(lb_ + q_ * 4096 - 2048) = RB[q_]; } } while (0)
#define SC_OUT(cidx, LN) do { const LAS unsigned char* st_ = L0 + SC_STG + w4 * 4096 + (LN) * 16; \
        bf16_t* op_ = ORAW + ((size_t)n * SEQ + 64 * (cidx) + 16 * w4 + ((LN) >> 4)) * 512 + hd * 128 + ((LN) & 15) * 8; \
        _Pragma("unroll") for (int q_ = 0; q_ < 4; ++q_) *(u32x4*)(op_ + (size_t)(4 * q_) * 512) = *(const LAS u32x4*)(st_ + q_ * 1024); } while (0)
      SC_LD_A(RA0, 0, lane); SC_LD_B(RB0, 0, lane); SC_LD_A(RA1, 1, lane); SC_LD_B(RB1, 1, lane);
      SC_ST_A(RA0, 0, lane); SC_ST_B(RB0, 0, lane); SC_ST_A(RA1, 1, lane);
      SC_LD_A(RA0, 2, lane); SC_LD_B(RB0, 2, lane); SC_LD_A(RA1, 3, lane);
      SC_BAR();
      for (int c2 = 0; c2 < NCH; c2 += 2) {
        int ln = lane; asm volatile("" : "+v"(ln));
        SC_BAR(); SC_OUT(c2, ln); SC_ST_B(RB1, 1, ln); SC_LD_B(RB1, c2 + 3, ln);
        SC_BAR(); SC_ST_A(RA0, 0, ln); SC_LD_A(RA0, c2 + 4, ln);
        SC_BAR(); SC_OUT(c2 + 1, ln); SC_ST_B(RB0, 0, ln); SC_LD_B(RB0, c2 + 4, ln);
        SC_BAR(); SC_ST_A(RA1, 1, ln); SC_LD_A(RA1, c2 + 5, ln);
      }
#undef SC_LD_A
#undef SC_LD_B
#undef SC_ST_A
#undef SC_ST_B
#undef SC_OUT
    }
    VM_WAIT();
    __syncthreads();
#undef SC_BAR
#undef SC_PIN
}

__device__ __forceinline__ void p2_mixprep(Ctx& C) {
    constexpr int N_PREP = NB * NHD * NCH, N_SD = SB * NHD, N_SA = SB * ATH * 6 / NWAVES;
    for (int it = C.bid; it < N_SD; it += C.G) smp_delta_item(C, it);
    const int a0 = C.G - 1 - C.bid, slot = a0 < N_SA ? (a0 & 7) : -1;
    for (int it = a0 + C.G; it < N_SA; it += C.G) smp_attn_task(C, it * NWAVES + C.wave);
    if (slot == 0) smp_attn_task(C, a0 * NWAVES + C.wave);
    __syncthreads();
    { PrepPre P; int it = C.bid;
      if (it < N_PREP) prep_prefetch(C, it, P);
      if (slot > 0) {
          for (int k = 0; it < N_PREP && k < slot; it += C.G, ++k) gdn_prep_item(C, it, P, (k + 1 < slot && it + C.G < N_PREP) ? it + C.G : -1);
          smp_attn_task(C, a0 * NWAVES + C.wave);
          if (it < N_PREP) prep_prefetch(C, it, P); }
      for (; it < N_PREP; it += C.G) gdn_prep_item(C, it, P, it + C.G < N_PREP ? it + C.G : -1); }
}
__device__ __forceinline__ void p3_scan(Ctx& C) {
    constexpr int N_SCAN = NB * NHD, N_ATT = NB * ATH * 96;
    if (C.bid < N_SCAN) gdn_scan_item(C, C.bid);
    else { const int part = C.bid - N_SCAN, np = C.G - N_SCAN;
        if ((part >> 3) & 1) { attn_phase(C, N_ATT, part, np); late_weight_copies(C, part, np); smp_window_copy(C, part, np); }
        else { late_weight_copies(C, part, np); smp_window_copy(C, part, np); attn_phase(C, N_ATT, part, np); } }
}

__device__ __forceinline__ void p4_combine(Ctx& C) {
    const int gw = C.bid * NWAVES + C.wave, NGW = C.G * NWAVES, lane = C.lane;
    const bf16_t* ORAW = WSP(bf16_t, WS_ORAW); const bf16_t* Z = WSP(bf16_t, WS_Z);
    const bf16_t* O1 = WSP(bf16_t, WS_O1); const bf16_t* O2 = WSP(bf16_t, WS_O2); const bf16_t* O3 = WSP(bf16_t, WS_O3);
    float nw[8];
#pragma unroll
    for (int e = 0; e < 8; ++e) nw[e] = C.dn_norm[(8 * lane + e) & 127];
    const float* LSE = WSP(float, WS_LSE); bf16_t* MIX = WSP(bf16_t, WS_MIX);
    for (int bh = gw; bh < SB * ATH; bh += NGW) smp_attn_merge(C, bh);
    for (int row = gw; row < M; row += NGW) {
        { const u32x4 ov = *(const u32x4*)(ORAW + (size_t)row * 512 + 8 * lane), zv = *(const u32x4*)(Z + (size_t)row * 512 + 8 * lane);
          float o[8], z[8];
          o[0] = bflo(ov.x); o[1] = bfhi(ov.x); o[2] = bflo(ov.y); o[3] = bfhi(ov.y); o[4] = bflo(ov.z); o[5] = bfhi(ov.z); o[6] = bflo(ov.w); o[7] = bfhi(ov.w);
          z[0] = bflo(zv.x); z[1] = bfhi(zv.x); z[2] = bflo(zv.y); z[3] = bfhi(zv.y); z[4] = bflo(zv.z); z[5] = bfhi(zv.z); z[6] = bflo(zv.w); z[7] = bfhi(zv.w);
          float s = 0.f;
#pragma unroll
          for (int e = 0; e < 8; ++e) s += o[e] * o[e];
          s += __shfl_xor(s, 1); s += __shfl_xor(s, 2); s += __shfl_xor(s, 4); s += __shfl_xor(s, 8);
          const float rs = rsqrtf(s * (1.f / DV) + EPS);
          float r[8];
#pragma unroll
          for (int e = 0; e < 8; ++e) r[e] = o[e] * rs * nw[e] * siluf(z[e]);
          u32x4 w; w.x = pkbf(r[0], r[1]); w.y = pkbf(r[2], r[3]); w.z = pkbf(r[4], r[5]); w.w = pkbf(r[6], r[7]);
          *(u32x4*)(MIX + (size_t)row * D + 8 * lane) = w; }
        const int h = lane >> 3;
        const float l1 = LSE[(size_t)row * 8 + h], l2 = LSE[(size_t)(M + row) * 8 + h], l3 = LSE[(size_t)(2 * M + row) * 8 + h];
        const float mx = fmaxf(l1, fmaxf(l2, l3));
        float w1 = exp2f(l1 - mx), w2 = exp2f(l2 - mx), w3 = exp2f(l3 - mx); const float inv = 1.f / (w1 + w2 + w3); w1 *= inv; w2 *= inv; w3 *= inv;
        const u32x4 a = *(const u32x4*)(O1 + (size_t)row * 512 + 8 * lane), b = *(const u32x4*)(O2 + (size_t)row * 512 + 8 * lane), c = *(const u32x4*)(O3 + (size_t)row * 512 + 8 * lane);
        u32x4 q;
        q.x = pkbf(w1 * bflo(a.x) + w2 * bflo(b.x) + w3 * bflo(c.x), w1 * bfhi(a.x) + w2 * bfhi(b.x) + w3 * bfhi(c.x));
        q.y = pkbf(w1 * bflo(a.y) + w2 * bflo(b.y) + w3 * bflo(c.y), w1 * bfhi(a.y) + w2 * bfhi(b.y) + w3 * bfhi(c.y));
        q.z = pkbf(w1 * bflo(a.z) + w2 * bflo(b.z) + w3 * bflo(c.z), w1 * bfhi(a.z) + w2 * bfhi(b.z) + w3 * bfhi(c.z));
        q.w = pkbf(w1 * bflo(a.w) + w2 * bflo(b.w) + w3 * bflo(c.w), w1 * bfhi(a.w) + w2 * bfhi(b.w) + w3 * bfhi(c.w));
        *(u32x4*)(MIX + (size_t)row * D + 512 + 8 * lane) = q;
    }
}

struct EpiOut {
    static constexpr bool PERM = true, AFTER_DRAIN = false;
    const float* x; float* x1; bf16_t* x1b; float* ssq;
    __device__ __forceinline__ void operator()(const f32x4 (&acc)[2][2][4][2], const pg8::Unit& u, int wr, int wc, int fr, int fq) const {
        const int row0 = u.pm * 256 + wr * 64 + fr, col0 = u.pn * 256 + wc * 32 + 8 * fq;
#pragma unroll
        for (int ai = 0; ai < 2; ++ai)
#pragma unroll
            for (int m = 0; m < 4; ++m) { const int r = row0 + ai * 128 + m * 16; float s = 0.f;
#pragma unroll
                for (int bj = 0; bj < 2; ++bj) { const size_t off = (size_t)r * D + col0 + bj * 128;
                    const f32x4 v0 = *(const f32x4*)(x + off) + acc[ai][bj][m][0], v1 = *(const f32x4*)(x + off + 4) + acc[ai][bj][m][1];
                    u32x4 w; w.x = pkbf(v0[0], v0[1]); w.y = pkbf(v0[2], v0[3]); w.z = pkbf(v1[0], v1[1]); w.w = pkbf(v1[2], v1[3]);
                    *(u32x4*)(x1b + off) = w;
                    s += (v0[0] * v0[0] + v0[1] * v0[1]) + (v0[2] * v0[2] + v0[3] * v0[3]) + (v1[0] * v1[0] + v1[1] * v1[1]) + (v1[2] * v1[2] + v1[3] * v1[3]); }
                s += __shfl_xor(s, 16); s += __shfl_xor(s, 32);
                if (fq == 0) ssq[(size_t)r * 16 + u.pn * 4 + wc] = s; }
    }
};
__device__ __forceinline__ void p5_outproj(Ctx& C) {
    pg8::Gemm g{WSP(bf16_t, WS_MIX), WSP(bf16_t, WS_WOUT), M, D, D}; pg8::StaticOrder S; S.init(M, D, C.G, C.bid);
    EpiOut E{C.x, C.out + O_Y, WSP(bf16_t, WS_X1B), WSP(float, WS_SSQ1)};
    pg8::gemm_phase<EpiOut, pg8::StaticOrder, true, true>(C.lds, g, S, E);
    float* XS1 = WSP(float, WS_XS1); const float* xs = C.xs;
    const ALoadBf16 AL{WSP(bf16_t, WS_SMIX), D};
    auto Ep = [XS1, xs](int row, int col, float v) { XS1[row * D + col] = xs[row * D + col] + v; };
    for (int it = C.bid; it < D / 32; it += C.G) sgemm32_item(it * 32, D, WSP(bf16_t, WS_WOUT), AL, Ep, (LAS float*)C.lds, C.tid);
}

struct EpiUp {
    static constexpr bool PERM = true, AFTER_DRAIN = false;
    bf16_t* H; const float* ssq; int rowoff;
    __device__ __forceinline__ void operator()(const f32x4 (&acc)[2][2][4][2], const pg8::Unit& u, int wr, int wc, int fr, int fq) const {
        const int row0 = rowoff + u.pm * 256 + wr * 64 + fr, col0 = u.pn * 256 + wc * 32 + 8 * fq;
#pragma unroll
        for (int ai = 0; ai < 2; ++ai)
#pragma unroll
            for (int m = 0; m < 4; ++m) { const int r = row0 + ai * 128 + m * 16;
                const f32x4 p = *(const f32x4*)(ssq + (size_t)r * 16 + 4 * fq); float t = (p.x + p.y) + (p.z + p.w);
                t += __shfl_xor(t, 16); t += __shfl_xor(t, 32);
                const float rstd = rsqrtf(t * (1.f / D) + EPS);
#pragma unroll
                for (int bj = 0; bj < 2; ++bj) { f32x4 v0 = acc[ai][bj][m][0] * rstd, v1 = acc[ai][bj][m][1] * rstd;
#pragma unroll
                    for (int e = 0; e < 4; ++e) { const float a = fmaxf(v0[e], 0.f), b = fmaxf(v1[e], 0.f); v0[e] = a * a; v1[e] = b * b; }
                    u32x4 w; w.x = pkbf(v0[0], v0[1]); w.y = pkbf(v0[2], v0[3]); w.z = pkbf(v1[0], v1[1]); w.w = pkbf(v1[2], v1[3]);
                    *(u32x4*)(H + (size_t)r * FF + col0 + bj * 128) = w; } }
    }
};
__device__ __forceinline__ void p6_up(Ctx& C, int half) {
    const int rowoff = half * (M / 2);
    pg8::Gemm g{WSP(bf16_t, WS_X1B) + (size_t)rowoff * D, WSP(bf16_t, WS_WUP), M / 2, FF, D}; pg8::StaticOrder S; S.init(M / 2, FF, C.G, C.bid);
    EpiUp E{WSP(bf16_t, WS_H), WSP(float, WS_SSQ1), rowoff};
    pg8::gemm_phase<EpiUp, pg8::StaticOrder, true, true>(C.lds, g, S, E);
    if (half == 0 && C.bid < FF / 32) {
        bf16_t* SH = WSP(bf16_t, WS_SH);
        const ALoadF32 AL{WSP(float, WS_XS1), D};
        auto Ep = [SH](int row, int col, float v) { const float a = fmaxf(v, 0.f); SH[row * FF + col] = (bf16_t)(pkbf(a * a, 0.f) & 0xffffu); };
        for (int it = C.bid; it < FF / 32; it += C.G) sgemm32_item(it * 32, D, WSP(bf16_t, WS_WUP), AL, Ep, (LAS float*)C.lds, C.tid);
    }
}

struct EpiDown {
    static constexpr bool PERM = true, AFTER_DRAIN = false;
    float* x1; const bf16_t* x1b; float* ssq; unsigned* cnt; const float* lnw; int rowoff;
    __device__ __forceinline__ void operator()(const f32x4 (&acc)[2][2][4][2], const pg8::Unit& u, int wr, int wc, int fr, int fq) const {
        const int row0 = rowoff + u.pm * 256 + wr * 64 + fr, col0 = u.pn * 256 + wc * 32 + 8 * fq;
        f32x4 v[2][4][2][2];
#pragma unroll
        for (int ai = 0; ai < 2; ++ai)
#pragma unroll
            for (int m = 0; m < 4; ++m) { const int r = row0 + ai * 128 + m * 16; float s = 0.f;
#pragma unroll
                for (int bj = 0; bj < 2; ++bj) { const size_t off = (size_t)r * D + col0 + bj * 128;
                    const u32x4 xb = *(const u32x4*)(x1b + off);
                    const f32x4 v0 = (f32x4){bflo(xb.x), bfhi(xb.x), bflo(xb.y), bfhi(xb.y)} + acc[ai][bj][m][0], v1 = (f32x4){bflo(xb.z), bfhi(xb.z), bflo(xb.w), bfhi(xb.w)} + acc[ai][bj][m][1];
                    v[ai][m][bj][0] = v0; v[ai][m][bj][1] = v1;
                    s += (v0[0] * v0[0] + v0[1] * v0[1]) + (v0[2] * v0[2] + v0[3] * v0[3]) + (v1[0] * v1[0] + v1[1] * v1[1]) + (v1[2] * v1[2] + v1[3] * v1[3]); }
                s += __shfl_xor(s, 16); s += __shfl_xor(s, 32);
                if (fq == 0) __hip_atomic_store(ssq + (size_t)r * 16 + u.pn * 4 + wc, s, __ATOMIC_RELAXED, __HIP_MEMORY_SCOPE_AGENT); }
        asm volatile("s_waitcnt vmcnt(0)" ::: "memory");
        unsigned* cp = cnt + 64 * (u.pm + (rowoff >> 8));
        if ((threadIdx.x & 63) == 0) __hip_atomic_fetch_add(cp, 1u, __ATOMIC_RELAXED, __HIP_MEMORY_SCOPE_AGENT);
        { unsigned spins = 0;
          for (;;) { unsigned v = 0u; if ((threadIdx.x & 63) == 0) v = __hip_atomic_load(cp, __ATOMIC_RELAXED, __HIP_MEMORY_SCOPE_AGENT);
              v = (unsigned)__builtin_amdgcn_readfirstlane((int)v); if (v >= 32u || ++spins > (1u << 18)) break; __builtin_amdgcn_s_sleep(8); } }
        __builtin_amdgcn_fence(__ATOMIC_ACQUIRE, "workgroup");
        f32x4 lw[2][2];
#pragma unroll
        for (int bj = 0; bj < 2; ++bj) { lw[bj][0] = *(const f32x4*)(lnw + col0 + bj * 128); lw[bj][1] = *(const f32x4*)(lnw + col0 + bj * 128 + 4); }
#pragma unroll
        for (int ai = 0; ai < 2; ++ai)
#pragma unroll
            for (int m = 0; m < 4; ++m) { const int r = row0 + ai * 128 + m * 16;
                const float* pp = ssq + (size_t)r * 16 + 4 * fq;
                const float p0 = __hip_atomic_load(pp, __ATOMIC_RELAXED, __HIP_MEMORY_SCOPE_AGENT), p1 = __hip_atomic_load(pp + 1, __ATOMIC_RELAXED, __HIP_MEMORY_SCOPE_AGENT),
                            p2 = __hip_atomic_load(pp + 2, __ATOMIC_RELAXED, __HIP_MEMORY_SCOPE_AGENT), p3 = __hip_atomic_load(pp + 3, __ATOMIC_RELAXED, __HIP_MEMORY_SCOPE_AGENT);
                float t = (p0 + p1) + (p2 + p3);
                t += __shfl_xor(t, 16); t += __shfl_xor(t, 32);
                const float rstd = rsqrtf(t * (1.f / D) + EPS);
#pragma unroll
                for (int bj = 0; bj < 2; ++bj) { const size_t off = (size_t)r * D + col0 + bj * 128;
                    *(f32x4*)(x1 + off) = v[ai][m][bj][0] * rstd * lw[bj][0]; *(f32x4*)(x1 + off + 4) = v[ai][m][bj][1] * rstd * lw[bj][1]; } }
    }
};
__device__ __forceinline__ void p7_down(Ctx& C, int half) {
    const int rowoff = half * (M / 2);
    pg8::Gemm g{WSP(bf16_t, WS_H) + (size_t)rowoff * FF, WSP(bf16_t, WS_WDN), M / 2, D, FF}; pg8::StaticOrder S; S.init(M / 2, D, C.G, C.bid);
    EpiDown E{C.out + O_Y, WSP(bf16_t, WS_X1B), WSP(float, WS_SSQ2), (unsigned*)(C.ws + WS_CTL) + CW_PANEL, C.ln_final, rowoff};
    pg8::gemm_phase<EpiDown, pg8::StaticOrder, true, true>(C.lds, g, S, E);
    if (half != 0) return;
    float* SPART = WSP(float, WS_SPART);
    const ALoadBf16 AL{WSP(bf16_t, WS_SH), FF};
    for (int it = C.bid; it < 8 * (D / 32); it += C.G) { const int cg = it & 31, kp = it >> 5;
        auto Ep = [SPART, kp](int row, int col, float v) { SPART[(kp * SB + row) * D + col] = v; };
        sgemm32_part(cg * 32, kp * (FF / 8), FF / 8, FF, WSP(bf16_t, WS_WDN), AL, Ep, (LAS float*)C.lds, C.tid); }
}

__device__ __forceinline__ void p8_final(Ctx& C) {
    const int gw = C.bid * NWAVES + C.wave, NGW = C.G * NWAVES, lane = C.lane;
    f32x4 lw[4];
#pragma unroll
    for (int j = 0; j < 4; ++j) lw[j] = ((const f32x4*)C.ln_final)[64 * j + lane];
    const float* XS1 = WSP(float, WS_XS1); const float* SPART = WSP(float, WS_SPART); float* YS = C.out + O_YS;
    for (int row = gw; row < SB; row += NGW) {
        f32x4 v[4], d[4]; float s1 = 0.f;
#pragma unroll
        for (int j = 0; j < 4; ++j) { v[j] = ((const f32x4*)(XS1 + row * D))[64 * j + lane]; s1 += (v[j].x * v[j].x + v[j].y * v[j].y) + (v[j].z * v[j].z + v[j].w * v[j].w); d[j] = (f32x4){0.f, 0.f, 0.f, 0.f}; }
#pragma unroll
        for (int kp = 0; kp < 8; ++kp)
#pragma unroll
            for (int j = 0; j < 4; ++j) d[j] += ((const f32x4*)(SPART + (size_t)(kp * SB + row) * D))[64 * j + lane];
        s1 = wave_sum(s1); const float r1 = rsqrtf(s1 * (1.f / D) + EPS), r2 = r1 * r1;
        float s = 0.f;
#pragma unroll
        for (int j = 0; j < 4; ++j) { v[j] += d[j] * r2; s += (v[j].x * v[j].x + v[j].y * v[j].y) + (v[j].z * v[j].z + v[j].w * v[j].w); }
        s = wave_sum(s); const float rstd = rsqrtf(s * (1.f / D) + EPS);
#pragma unroll
        for (int j = 0; j < 4; ++j) ((f32x4*)(YS + row * D))[64 * j + lane] = v[j] * rstd * lw[j];
    }
}

#ifndef MK_PER_PHASE
#define MK_PER_PHASE 0
#endif
constexpr int N_PHASES = 9;
struct Args { const float* in[17]; float* out; unsigned char* ws; int ph_lo, ph_hi; };
__global__ void __launch_bounds__(NTHREADS, 2) mk_fwd(Args args) {
    extern __shared__ __attribute__((aligned(16))) unsigned char lds_raw[];
    Ctx C;
    C.lds = (LAS unsigned char*)lds_raw;
    C.tid = threadIdx.x; C.lane = C.tid & 63; C.wave = __builtin_amdgcn_readfirstlane(C.tid >> 6); C.G = gridDim.x; C.bid = blockIdx.x;
    C.x = args.in[0]; C.xs = args.in[1]; C.st_conv = args.in[2]; C.st_ssm = args.in[3]; C.ck = args.in[4]; C.cv = args.in[5]; C.ln_mix = args.in[6]; C.w_in = args.in[7];
    C.conv_w = args.in[8]; C.a_log = args.in[9]; C.dt_bias = args.in[10]; C.dn_norm = args.in[11]; C.w_out = args.in[12]; C.ln_ffn = args.in[13]; C.w_up = args.in[14];
    C.w_dn = args.in[15]; C.ln_final = args.in[16]; C.out = args.out; C.ws = args.ws;
    volatile LAS unsigned* MISC = (volatile LAS unsigned*)(C.lds + MISC_OFF);
    for (int u = C.tid; u < (LDS_BYTES - LDSCTL_OFF) / 4; u += NTHREADS) ((LAS unsigned*)(C.lds + LDSCTL_OFF))[u] = 0u;
    __syncthreads();
    XcdBarrier bar; bar.bar = (unsigned*)(C.ws + WS_CTL) + CW_BAR; bar.x = 0; bar.st = nullptr;
    if (!MK_PER_PHASE) bar = xcd_barrier_post((unsigned*)(C.ws + WS_CTL) + CW_BAR, MISC + 8);
    const int lo = args.ph_lo, hi = args.ph_hi;
#define IN(k) (lo <= (k) && (k) < hi)
#define SEAM(k) do { if (IN(k) && IN((k) + 1)) xcd_barrier(bar); } while (0)
    if (IN(0)) p0_prologue(C);
    SEAM(0);
    if (IN(1)) p1_inproj(C);
    SEAM(1);
    if (IN(2)) p2_mixprep(C);
    SEAM(2);
    if (IN(3)) p3_scan(C);
    SEAM(3);
    if (IN(4)) p4_combine(C);
    SEAM(4);
    if (IN(5)) p5_outproj(C);
    SEAM(5);
    if (IN(6)) p6_up(C, 0);
    SEAM(6);
    if (IN(7)) { p7_down(C, 0); p6_up(C, 1); }
    SEAM(7);
    if (IN(8)) { p7_down(C, 1); p8_final(C); }
#undef IN
#undef SEAM
}

extern "C" void kernel_launch(void* const* d_in, const int* in_sizes, int n_in, void* d_out, int out_size, void* d_ws, size_t ws_size, hipStream_t stream) {
    static int grid = 0;
    if (grid == 0) {
        if (n_in != 17 || (size_t)out_size != O_END || ws_size < WS_END) { fprintf(stderr, "kernel_launch: unexpected shapes (n_in %d out %d ws %zu)\n", n_in, out_size, ws_size); grid = -1; return; }
        int dev = 0, cus = 0;
        if (hipGetDevice(&dev) != hipSuccess || hipDeviceGetAttribute(&cus, hipDeviceAttributeMultiprocessorCount, dev) != hipSuccess) { grid = -1; return; }
        if (hipFuncSetAttribute((const void*)mk_fwd, hipFuncAttributeMaxDynamicSharedMemorySize, LDS_BYTES) != hipSuccess) { fprintf(stderr, "kernel_launch: hipFuncSetAttribute failed\n"); grid = -1; return; }
        int per_cu = 0;
        (void)hipOccupancyMaxActiveBlocksPerMultiprocessor(&per_cu, (const void*)mk_fwd, NTHREADS, LDS_BYTES);
        (void)hipGetLastError();
        grid = cus;
        if (grid != 256) fprintf(stderr, "kernel_launch: note: %d CUs (built for 256)\n", grid);
    }
    if (grid < 0) return;
    (void)hipMemsetAsync((char*)d_ws + WS_CTL, 0, CTL_ZERO_BYTES, stream);
    Args a{};
    for (int i = 0; i < 17; ++i) a.in[i] = (const float*)d_in[i];
    a.out = (float*)d_out; a.ws = (unsigned char*)d_ws;
#if MK_PER_PHASE
    for (int p = 0; p < N_PHASES; ++p) { a.ph_lo = p; a.ph_hi = p + 1; hipLaunchKernelGGL(mk_fwd, dim3(grid), dim3(NTHREADS), LDS_BYTES, stream, a); }
#else
    a.ph_lo = 0; a.ph_hi = N_PHASES; hipLaunchKernelGGL(mk_fwd, dim3(grid), dim3(NTHREADS), LDS_BYTES, stream, a);
#endif
}
```

```cpp
#include <hip/hip_runtime.h>
#include <cstdio>
#include <cstdint>
namespace pg8 {
#define PG8_LAS __attribute__((address_space(3)))
typedef unsigned short bf16_t;
typedef short bf16x8 __attribute__((ext_vector_type(8)));
typedef float f32x4 __attribute__((ext_vector_type(4)));
typedef unsigned u32x4 __attribute__((ext_vector_type(4)));
constexpr int BM = 256, BK = 64, HALF = 128, HTB = HALF * BK * 2  , STAGE_BYTES = 8 * HTB, NXCD = 8, WGM = 8;

__host__ __device__ __forceinline__ int lds_byte(int r, int c) { const int st = (r >> 4) * 2 + (c >> 5), rr = r & 15, cc = c & 31, ob = rr * 64 + cc * 2; return st * 1024 + (ob ^ (((ob >> 9) & 1) << 5)); }
__host__ __device__ __forceinline__ void stage_rc(int b, int& R, int& C) { const int st = b / 1024, sb = b % 1024, swz = sb ^ (((sb >> 9) & 1) << 5); R = (st >> 1) * 16 + swz / 64; C = (st & 1) * 32 + (swz % 64) / 2; }
__host__ __device__ __forceinline__ int perm32(int rho) { const int n = rho >> 4, i = rho & 15; return 8 * (i >> 2) + 4 * n + (i & 3); }

struct Unit { int pm, pn; };
struct Gemm { const bf16_t* A; const bf16_t* Bt; int M, N, K; };

struct StaticOrder {
    int nM, nN, nwg, G, c;
    __host__ __device__ void init(int M, int N, int G_, int c_) { nM = M / BM; nN = N / BM; nwg = nM * nN; G = G_; c = c_; }
    __host__ __device__ bool next(int i, Unit& u) const {
        const long L = (long)i * G + c; if (L >= nwg) return false;
        int wgid = (int)L; { const int q = nwg / NXCD, r = nwg % NXCD, xcd = wgid % NXCD, off = wgid / NXCD; wgid = (xcd < r ? xcd * (q + 1) : r * (q + 1) + (xcd - r) * q) + off; }
        const int nig = WGM * nN, gid = wgid / nig, fm = gid * WGM, gsz = (nM - fm) < WGM ? (nM - fm) : WGM;
        u.pm = fm + ((wgid % nig) % gsz); u.pn = (wgid % nig) / gsz; return true;
    }
    __device__ __forceinline__ void a_ready(const Unit&) const {}
    __device__ __forceinline__ void done(const Unit&) const {}
};

template <class Epi, class Sched, bool ALIGN_EPI = false, bool SP2 = false>
__device__ __forceinline__ void gemm_phase(PG8_LAS unsigned char* lds, const Gemm g, const Sched& S, const Epi& E) {
    const int tid = threadIdx.x, wid = __builtin_amdgcn_readfirstlane(tid >> 6), lane = tid & 63, wr = wid >> 2, wc = wid & 3, fr = lane & 15, fq = lane >> 4;
    const int K = g.K, nt = K / BK;
    unsigned voffA[2], voffB[2];
#pragma unroll
    for (int i = 0; i < 2; ++i) { int R, C; stage_rc(tid * 16 + i * 8192, R, C); const int Rb = Epi::PERM ? ((R & ~31) + perm32(R & 31)) : R;
        voffA[i] = (unsigned)(R * K + C) * 2u; voffB[i] = (unsigned)(Rb * K + C) * 2u; }
    const size_t kstep = (size_t)(BK * 2);
    const size_t hstep = (size_t)HALF * K * 2;
    const size_t tstep = 2 * hstep;
    const unsigned ldsw = (unsigned)wid * 1024u;
    const int aoff = lds_byte(wr * 64 + fr, fq * 8), boff = lds_byte(wc * 32 + fr, fq * 8);
#define PG8_SA(b, h) (((b) * 2 + (h)) * HTB)
#define PG8_SB(b, h) ((4 + (b) * 2 + (h)) * HTB)
#define PG8_STAGE(bufoff, gbase, voff) do { _Pragma("unroll") for (int _i = 0; _i < 2; ++_i) \
        __builtin_amdgcn_global_load_lds((const unsigned*)((const char*)(gbase) + (voff)[_i]), (PG8_LAS unsigned*)(lds + (bufoff) + ldsw + _i * 8192), 16, 0, 0); } while (0)
#define PG8_LDA(dst, b, h) do { _Pragma("unroll") for (int m = 0; m < 4; ++m) _Pragma("unroll") for (int k = 0; k < 2; ++k) dst[m][k] = *(const PG8_LAS bf16x8*)(lds + PG8_SA(b, h) + aoff + m * 2048 + k * 1024); } while (0)
#define PG8_LDB(dst, b, h) do { _Pragma("unroll") for (int n = 0; n < 2; ++n) _Pragma("unroll") for (int k = 0; k < 2; ++k) dst[n][k] = *(const PG8_LAS bf16x8*)(lds + PG8_SB(b, h) + boff + n * 2048 + k * 1024); } while (0)
#define PG8_MMA(ai, bj, At, Bt) do { __builtin_amdgcn_s_setprio(1); _Pragma("unroll") for (int m = 0; m < 4; ++m) _Pragma("unroll") for (int n = 0; n < 2; ++n) _Pragma("unroll") for (int k = 0; k < 2; ++k) \
        acc[ai][bj][m][n] = __builtin_amdgcn_mfma_f32_16x16x32_bf16(Bt[n][k], At[m][k], acc[ai][bj][m][n], 0, 0, 0); __builtin_amdgcn_s_setprio(0); } while (0)
#define PG8_WAIT_V(n) asm volatile("s_waitcnt vmcnt(" #n ")" ::: "memory")
#define PG8_WAIT_L(n) asm volatile("s_waitcnt lgkmcnt(" #n ")" ::: "memory")
#define PG8_BAR __builtin_amdgcn_s_barrier()
#define PG8_SCHED __builtin_amdgcn_sched_barrier(0)
    Unit cur, nxt; int ui = 0;
    if (!S.next(0, cur)) return;
    f32x4 acc[2][2][4][2];
#pragma unroll
    for (int a = 0; a < 2; ++a)
#pragma unroll
        for (int b = 0; b < 2; ++b)
#pragma unroll
            for (int m = 0; m < 4; ++m)
#pragma unroll
                for (int n = 0; n < 2; ++n) acc[a][b][m][n] = (f32x4){0.f, 0.f, 0.f, 0.f};
    bf16x8 At[4][2], B0[2][2], B1[2][2];
    const char* cA = (const char*)g.A + (size_t)cur.pm * tstep; const char* cB = (const char*)g.Bt + (size_t)cur.pn * tstep;
    S.a_ready(cur);
    if constexpr (SP2) {
        PG8_STAGE(PG8_SB(0, 0), cB, voffB); PG8_STAGE(PG8_SB(0, 1), cB + hstep, voffB); PG8_STAGE(PG8_SA(0, 0), cA, voffA); PG8_STAGE(PG8_SA(0, 1), cA + hstep, voffA);
        if (wr == 1) PG8_BAR;
        PG8_WAIT_V(2); PG8_BAR;
        PG8_STAGE(PG8_SB(1, 0), cB + kstep, voffB); PG8_STAGE(PG8_SA(1, 0), cA + kstep, voffA); PG8_STAGE(PG8_SB(1, 1), cB + hstep + kstep, voffB);
        PG8_WAIT_V(6); PG8_BAR;
    } else {
        PG8_STAGE(PG8_SB(0, 0), cB, voffB); PG8_STAGE(PG8_SA(0, 0), cA, voffA); PG8_STAGE(PG8_SB(0, 1), cB + hstep, voffB); PG8_STAGE(PG8_SA(0, 1), cA + hstep, voffA);
        if (wr == 1) PG8_BAR;
        PG8_WAIT_V(4); PG8_BAR;
        PG8_STAGE(PG8_SB(1, 0), cB + kstep, voffB); PG8_STAGE(PG8_SA(1, 0), cA + kstep, voffA); PG8_STAGE(PG8_SB(1, 1), cB + hstep + kstep, voffB);
        PG8_WAIT_V(6); PG8_BAR;
    }
    for (;;) {
        const bool has_next = S.next(ui + 1, nxt);
        const char* nA = has_next ? (const char*)g.A + (size_t)nxt.pm * tstep : cA; const char* nB = has_next ? (const char*)g.Bt + (size_t)nxt.pn * tstep : cB;
        for (int t = 0; t < nt; t += 2) {
            const bool last = (t == nt - 2);
            const char* a1 = cA + (size_t)(t + 1) * kstep;
            const char* a2 = last ? nA : cA + (size_t)(t + 2) * kstep; const char* b2 = last ? nB : cB + (size_t)(t + 2) * kstep;
            const char* a3 = a2 + kstep; const char* b3 = b2 + kstep;
            if (last && has_next) S.a_ready(nxt);
            if constexpr (SP2) {
            PG8_LDB(B0, 0, 0); PG8_LDB(B1, 0, 1); PG8_SCHED; PG8_LDA(At, 0, 0); PG8_STAGE(PG8_SA(1, 1), a1 + hstep, voffA);
            PG8_WAIT_V(8); PG8_WAIT_L(0); PG8_BAR; PG8_MMA(0, 0, At, B0); PG8_MMA(0, 1, At, B1); PG8_BAR; PG8_SCHED;
            PG8_LDA(At, 0, 1); PG8_STAGE(PG8_SB(0, 0), b2, voffB); PG8_STAGE(PG8_SB(0, 1), b2 + hstep, voffB); PG8_STAGE(PG8_SA(0, 0), a2, voffA);
            PG8_WAIT_V(8); PG8_WAIT_L(0); PG8_BAR; PG8_MMA(1, 0, At, B0); PG8_MMA(1, 1, At, B1); PG8_BAR; PG8_SCHED;
            PG8_LDB(B0, 1, 0); PG8_LDB(B1, 1, 1); PG8_SCHED; PG8_LDA(At, 1, 0); PG8_STAGE(PG8_SA(0, 1), a2 + hstep, voffA);
            PG8_WAIT_V(8); PG8_WAIT_L(0); PG8_BAR; PG8_MMA(0, 0, At, B0); PG8_MMA(0, 1, At, B1); PG8_BAR; PG8_SCHED;
            PG8_LDA(At, 1, 1); PG8_STAGE(PG8_SB(1, 0), b3, voffB); PG8_STAGE(PG8_SB(1, 1), b3 + hstep, voffB); PG8_STAGE(PG8_SA(1, 0), a3, voffA);
            PG8_WAIT_V(8); PG8_WAIT_L(0); PG8_BAR; PG8_MMA(1, 0, At, B0); PG8_MMA(1, 1, At, B1); PG8_BAR; PG8_SCHED;
            } else {
            PG8_LDB(B0, 0, 0); PG8_SCHED; PG8_LDA(At, 0, 0); PG8_STAGE(PG8_SA(1, 1), a1 + hstep, voffA);
            PG8_WAIT_L(8); PG8_BAR; PG8_WAIT_L(0); PG8_MMA(0, 0, At, B0); PG8_BAR; PG8_SCHED;
            PG8_LDB(B1, 0, 1); PG8_STAGE(PG8_SB(0, 0), b2, voffB);
            PG8_BAR; PG8_WAIT_L(0); PG8_MMA(0, 1, At, B1); PG8_BAR;
            PG8_LDA(At, 0, 1); PG8_STAGE(PG8_SA(0, 0), a2, voffA);
            PG8_BAR; PG8_WAIT_L(0); PG8_MMA(1, 0, At, B0); PG8_BAR; PG8_SCHED;
            PG8_STAGE(PG8_SB(0, 1), b2 + hstep, voffB);
            PG8_WAIT_V(6); PG8_BAR; PG8_MMA(1, 1, At, B1); PG8_BAR;
            PG8_LDB(B0, 1, 0); PG8_SCHED; PG8_LDA(At, 1, 0); PG8_STAGE(PG8_SA(0, 1), a2 + hstep, voffA);
            PG8_WAIT_L(8); PG8_BAR; PG8_WAIT_L(0); PG8_MMA(0, 0, At, B0); PG8_BAR; PG8_SCHED;
            PG8_LDB(B1, 1, 1); PG8_STAGE(PG8_SB(1, 0), b3, voffB);
            PG8_BAR; PG8_WAIT_L(0); PG8_MMA(0, 1, At, B1); PG8_BAR;
            PG8_LDA(At, 1, 1); PG8_STAGE(PG8_SA(1, 0), a3, voffA);
            PG8_BAR; PG8_WAIT_L(0); PG8_MMA(1, 0, At, B0); PG8_BAR; PG8_SCHED;
            PG8_STAGE(PG8_SB(1, 1), b3 + hstep, voffB);
            PG8_WAIT_V(6); PG8_BAR; PG8_MMA(1, 1, At, B1); PG8_BAR;
            }
        }
        if constexpr (ALIGN_EPI) { if (wr == 0) PG8_BAR; }
        if constexpr (!Epi::AFTER_DRAIN) { E(acc, cur, wr, wc, fr, fq); S.done(cur); }
        if (!has_next) break;
#pragma unroll
        for (int a = 0; a < 2; ++a)
#pragma unroll
            for (int b = 0; b < 2; ++b)
#pragma unroll
                for (int m = 0; m < 4; ++m)
#pragma unroll
                    for (int n = 0; n < 2; ++n) acc[a][b][m][n] = (f32x4){0.f, 0.f, 0.f, 0.f};
        cur = nxt; cA = nA; cB = nB; ++ui;
        if constexpr (ALIGN_EPI) { if (wr == 1) PG8_BAR; }
    }
    PG8_WAIT_V(0);
    if constexpr (!ALIGN_EPI) { if (wr == 0) PG8_BAR; }
    PG8_BAR;
    if constexpr (Epi::AFTER_DRAIN) { E.fused(acc, cur, wr, wc, fr, fq, lds, wid, lane); S.done(cur); }
#undef PG8_SA
#undef PG8_SB
#undef PG8_STAGE
#undef PG8_LDA
#undef PG8_LDB
#undef PG8_MMA
#undef PG8_WAIT_V
#undef PG8_WAIT_L
#undef PG8_BAR
#undef PG8_SCHED
}
}
#define LAS __attribute__((address_space(3)))
#define XB_TMO      128
#define XB_XCNT(j)  (256  + 64 * (j))
#define XB_XSUB(j)  (1280 + 64 * (j))
#define XB_XGEN(j)  (2304 + 64 * (j))
#define XB_TOP      3328
#define XB_TOPGEN   3392
#define XCD_BAR_WORDS 3456
#define XB_SPIN_CAP (1u << 18)

__device__ __forceinline__ unsigned xb_ld(unsigned* p)              { return __hip_atomic_load(p, __ATOMIC_RELAXED, __HIP_MEMORY_SCOPE_AGENT); }
__device__ __forceinline__ unsigned xb_add(unsigned* p, unsigned v) { return __hip_atomic_fetch_add(p, v, __ATOMIC_RELAXED, __HIP_MEMORY_SCOPE_AGENT); }
__device__ __forceinline__ unsigned xb_xcc_id() { return (unsigned)__builtin_amdgcn_s_getreg((3 << 11) | 20) & 0xFu; }
#define XB_SPIN(cond, bar) do { unsigned _sp = 0; while (cond) { __builtin_amdgcn_s_sleep(1); \
    if ((++_sp & 255u) == 0u) { if (xb_ld(&(bar)[XB_TMO])) break; if (_sp > XB_SPIN_CAP) { atomicAdd(&(bar)[XB_TMO], 1u); break; } } } } while (0)

struct XcdBarrier {
    unsigned* bar; unsigned x;
    volatile LAS unsigned* st;
};

__device__ __forceinline__ XcdBarrier xcd_barrier_post(unsigned* bar, volatile LAS unsigned* st) {
    XcdBarrier b; b.bar = bar; b.x = xb_xcc_id(); b.st = st;
    if (threadIdx.x == 0) (void)xb_add(&bar[XB_XCNT(b.x)], 1u);
    return b;
}
__device__ __forceinline__ void xcd_barrier_complete(unsigned* bar, unsigned x, unsigned& nloc, unsigned& nx) {
    const unsigned G = gridDim.x * gridDim.y * gridDim.z;
    unsigned sum, cnt, mine, sp = 0u;
    for (;;) {
        sum = 0u; cnt = 0u; mine = 0u;
#pragma unroll
        for (unsigned j = 0; j < 16; ++j) { const unsigned c = xb_ld(&bar[XB_XCNT(j)]); sum += c; cnt += (c > 0u) ? 1u : 0u; mine = (j == x) ? c : mine; }
        if (sum == G) break;
        __builtin_amdgcn_s_sleep(1);
        if ((++sp & 255u) == 0u) { if (xb_ld(&bar[XB_TMO])) break; if (sp > XB_SPIN_CAP) { atomicAdd(&bar[XB_TMO], 1u); break; } }
    }
    nloc = mine > 0u ? mine : 1u; nx = cnt > 0u ? cnt : 1u;
}

__device__ __forceinline__ void xcd_barrier(const XcdBarrier& b) {
    asm volatile("s_waitcnt vmcnt(0)" ::: "memory");
    __syncthreads();
    if (threadIdx.x == 0) {
        unsigned* bar = b.bar;
        __builtin_amdgcn_s_waitcnt(0);
        unsigned nloc = b.st[0], nx = b.st[1];
        if (nloc == 0u) { xcd_barrier_complete(bar, b.x, nloc, nx); b.st[0] = nloc; b.st[1] = nx; }
        const unsigned old = xb_add(&bar[XB_XSUB(b.x)], 1u);
        const unsigned gen = old / nloc;
        if (old + 1u == (gen + 1u) * nloc) {
            __builtin_amdgcn_fence(__ATOMIC_RELEASE, "agent");
            asm volatile("s_waitcnt vmcnt(0)" ::: "memory");
            const unsigned og = xb_add(&bar[XB_TOP], 1u);
            const unsigned tg = og / nx, goal = (tg + 1u) * nx;
            if (og + 1u != goal) XB_SPIN(xb_ld(&bar[XB_TOP]) < goal, bar);
            xb_add(&bar[XB_XGEN(b.x)], 1u);
            __builtin_amdgcn_fence(__ATOMIC_ACQUIRE, "agent");
            asm volatile("s_waitcnt vmcnt(0)" ::: "memory");
        } else {
            XB_SPIN(xb_ld(&bar[XB_XGEN(b.x)]) == gen, bar);
            __builtin_amdgcn_fence(__ATOMIC_ACQUIRE, "agent");
            asm volatile("s_waitcnt vmcnt(0)" ::: "memory");
        }
    }
    __syncthreads();
}
#undef LAS

#define GAS __attribute__((address_space(1)))
#define LAS __attribute__((address_space(3)))
using pg8::bf16_t; using pg8::bf16x8; using pg8::f32x4; using pg8::u32x4;
typedef float f32x16 __attribute__((ext_vector_type(16)));
typedef float f32x2 __attribute__((ext_vector_type(2)));
typedef unsigned u32x2 __attribute__((ext_vector_type(2)));
typedef short s16x4 __attribute__((ext_vector_type(4)));

constexpr int NWAVES = 8, NTHREADS = 512;
constexpr int D = 1024, NB = 8, SEQ = 4096, M = NB * SEQ, SB = 32;
constexpr int CONV_CH = 1536, NHD = 4, DK = 128, DV = 128, ATH = 8, ATD = 64, ATW = 512;
constexpr int IN_DIM = 3592, NIN = 3584, FF = 4096, WIN = 2048, NCH = SEQ / 64;
constexpr float EPS = 1e-6f;
constexpr float LOG2E = 1.4426950408889634f;
constexpr float QSCALE = 0.125f * LOG2E;

constexpr size_t O_Y = 0, O_YS = 33554432, O_PCONV = 33587200, O_PSSM = 33624064, O_PWK = 34148352, O_PWV = 42536960,
                 O_SCONV = 50925568, O_SSSM = 51073024, O_SWK = 53170176, O_SWV = 86724608, O_END = 120279040;

constexpr size_t MiB = 1u << 20;
constexpr size_t WS_CTL = 0, CTL_ZERO_BYTES = 128 * 1024;
constexpr size_t WS_WIN = 2 * MiB, WS_WOUT = 10 * MiB, WS_WUP = 12 * MiB, WS_WDN = 20 * MiB;
constexpr size_t WS_BETA = 28 * MiB, WS_GG = WS_BETA + 512 * 1024, WS_EGL = 29 * MiB;
constexpr size_t WS_SSQ1 = 30 * MiB, WS_SSQ2 = 32 * MiB, WS_LSE = 34 * MiB;
constexpr size_t WS_S = 37 * MiB;
constexpr size_t WS_XSN = WS_S, WS_SGATE = WS_S + 64 * 1024, WS_SPROJ = WS_S + 128 * 1024, WS_SMIX = WS_S + 640 * 1024,
                 WS_XS1 = WS_S + 704 * 1024, WS_SH = WS_S + 832 * 1024, WS_XS2 = WS_S + 1088 * 1024, WS_SATT = WS_S + 1280 * 1024;
constexpr size_t WS_SPART = 39 * MiB;
constexpr size_t WS_XN = 40 * MiB;
constexpr size_t WS_O1 = 40 * MiB, WS_O2 = 72 * MiB, WS_X1B = 40 * MiB;
constexpr size_t WS_PRE = 104 * MiB;
constexpr size_t WS_MIX = 104 * MiB, WS_H = 104 * MiB;
constexpr size_t WS_Z = 200 * MiB;
constexpr size_t WS_QA = 232 * MiB, WS_KA = 264 * MiB, WS_VA = 296 * MiB;
constexpr size_t WS_ORAW = 168 * MiB;
constexpr size_t WS_GDN = 328 * MiB;
constexpr size_t WS_O3 = 472 * MiB;
constexpr size_t WS_END = 504 * MiB;
constexpr int GDN_CHUNK_BYTES = 73728;
constexpr int GI_NW = 0, GI_QG = 16384, GI_QK = 32768, GI_KD = 40960, GI_U = 57344;

constexpr int CW_TMO = 0, CW_BAR = 4096, CW_PANEL = 16384;

constexpr int RING_BYTES = 131072, LDSCTL_OFF = 159744, MISC_OFF = LDSCTL_OFF + 320, LDS_BYTES = 160768;

#define LDS_WAIT() asm volatile("s_waitcnt lgkmcnt(0)" ::: "memory")
#define VM_WAIT() asm volatile("s_waitcnt vmcnt(0)" ::: "memory")

__device__ __forceinline__ unsigned pkbf(float lo, float hi) {
    typedef __bf16 bf2_t __attribute__((ext_vector_type(2)));
    f32x2 v = {lo, hi}; bf2_t b = __builtin_convertvector(v, bf2_t); return __builtin_bit_cast(unsigned, b);
}
__device__ __forceinline__ float bflo(unsigned u) { return __uint_as_float(u << 16); }
__device__ __forceinline__ float bfhi(unsigned u) { return __uint_as_float(u & 0xffff0000u); }
__device__ __forceinline__ float wave_sum(float v) {
#pragma unroll
    for (int o = 1; o < 64; o <<= 1) v += __shfl_xor(v, o);
    return v;
}
__device__ __forceinline__ float siluf(float x) { return x * __builtin_amdgcn_rcpf(1.f + __expf(-x)); }
__device__ __forceinline__ float sigmoidf_(float x) { return 1.f / (1.f + __expf(-x)); }
__device__ __forceinline__ float softplusf_(float x) { return x > 20.f ? x : log1pf(__expf(x)); }


struct Ctx {
    LAS unsigned char* lds;
    int tid, lane, wave, G, bid;
    const float *x, *xs, *st_conv, *st_ssm, *ck, *cv, *ln_mix, *w_in, *conv_w, *a_log, *dt_bias, *dn_norm, *w_out, *ln_ffn, *w_up, *w_dn, *ln_final;
    float* out; unsigned char* ws;
};
#define WSP(T, off) ((T*)(C.ws + (off)))

__device__ __forceinline__ void transpose_item(const float* __restrict__ W, int ldw, int srccol0, int k0, const float* __restrict__ kscale, bf16_t* WT, int K, int dstrow0, LAS float* scr, int lane) {
    float tv[32];
#pragma unroll
    for (int i = 0; i < 32; ++i) tv[i] = W[(size_t)(k0 + 2 * i + (lane >> 5)) * ldw + srccol0 + (lane & 31)];
#pragma unroll
    for (int i = 0; i < 32; ++i) { const int kk = 2 * i + (lane >> 5); float v = tv[i]; if (kscale) v *= kscale[k0 + kk]; scr[kk * 33 + (lane & 31)] = v; }
    LDS_WAIT(); asm volatile("" ::: "memory");
    const int c = lane & 7;
#pragma unroll
    for (int j = 0; j < 4; ++j) { const int n = (lane >> 3) + 8 * j; const LAS float* s = scr + (8 * c) * 33 + n;
        u32x4 o; o.x = pkbf(s[0 * 33], s[1 * 33]); o.y = pkbf(s[2 * 33], s[3 * 33]); o.z = pkbf(s[4 * 33], s[5 * 33]); o.w = pkbf(s[6 * 33], s[7 * 33]);
        *(u32x4*)(WT + (size_t)(dstrow0 + n) * K + k0 + 8 * c) = o; }
    LDS_WAIT(); asm volatile("" ::: "memory");
}

__device__ __forceinline__ void late_weight_copies(Ctx& C, int part, int nparts) {
    const int gw = part * NWAVES + C.wave, NGW = nparts * NWAVES, lane = C.lane;
    LAS float* scr = (LAS float*)(C.lds + C.wave * 16384);
    constexpr int I_OUT = (D / 64) * (D / 32), I_UP = (D / 64) * (FF / 32), I_DN = (FF / 64) * (D / 32);
    for (int it = gw; it < I_OUT + I_UP + I_DN; it += NGW) {
        const int q9 = it / 9, m9 = it % 9;
        if (m9 == 0) { const int r = q9; const int nblk = D / 32, kb = r / nblk, nb = r % nblk;
            transpose_item(C.w_out, D, nb * 32, 64 * kb, nullptr, WSP(bf16_t, WS_WOUT), D, nb * 32, scr, lane); }
        else if (m9 < 5) { const int r = q9 * 4 + (m9 - 1); const int nblk = FF / 32, kb = r / nblk, nb = r % nblk;
            transpose_item(C.w_up, FF, nb * 32, 64 * kb, C.ln_ffn, WSP(bf16_t, WS_WUP), D, nb * 32, scr, lane); }
        else { const int r = q9 * 4 + (m9 - 5); const int nblk = D / 32, kb = r / nblk, nb = r % nblk;
            transpose_item(C.w_dn, D, nb * 32, 64 * kb, nullptr, WSP(bf16_t, WS_WDN), FF, nb * 32, scr, lane); }
    }
    __syncthreads();
}
__device__ __forceinline__ void p0_prologue(Ctx& C) {
    const int gw = C.bid * NWAVES + C.wave, NGW = C.G * NWAVES, lane = C.lane;
    {
        LAS float* scr = (LAS float*)(C.lds + C.wave * 16384);
        constexpr int I_IN = (D / 64) * (NIN / 32);
        for (int it = gw; it < I_IN; it += NGW) { const int nblk = NIN / 32, kb = it / nblk, nb = it % nblk; const int src = nb * 32 + (nb >= 64 ? 8 : 0);
            transpose_item(C.w_in, IN_DIM, src, 64 * kb, nullptr, WSP(bf16_t, WS_WIN), D, nb * 32, scr, lane); }
    }
    __syncthreads();
    LAS float* wg = (LAS float*)C.lds;
    for (int idx = C.tid; idx < 8192; idx += NTHREADS) { const int k = idx >> 3, g = idx & 7; wg[g * 1024 + k] = C.w_in[(size_t)k * IN_DIM + 2048 + g]; }
    __syncthreads();
    f32x4 lw[4];
#pragma unroll
    for (int j = 0; j < 4; ++j) lw[j] = ((const f32x4*)C.ln_mix)[64 * j + lane];
    bf16_t* XN = WSP(bf16_t, WS_XN); bf16_t* XSN = WSP(bf16_t, WS_XSN);
    float* BETA = WSP(float, WS_BETA); float* GG = WSP(float, WS_GG); float* SG = WSP(float, WS_SGATE);
    for (int row = gw; row < M + SB; row += NGW) {
        const bool smp = row >= M;
        const float* xr = smp ? C.xs + (size_t)(row - M) * D : C.x + (size_t)row * D;
        f32x4 v[4]; float s = 0.f;
#pragma unroll
        for (int j = 0; j < 4; ++j) { v[j] = ((const f32x4*)xr)[64 * j + lane]; s += (v[j].x * v[j].x + v[j].y * v[j].y) + (v[j].z * v[j].z + v[j].w * v[j].w); }
        s = wave_sum(s);
        const float rstd = rsqrtf(s * (1.f / D) + EPS);
#pragma unroll
        for (int j = 0; j < 4; ++j) v[j] = v[j] * rstd * lw[j];
        bf16_t* orow = smp ? XSN + (size_t)(row - M) * D : XN + (size_t)row * D;
#pragma unroll
        for (int j = 0; j < 4; ++j) { u32x2 o; o.x = pkbf(v[j].x, v[j].y); o.y = pkbf(v[j].z, v[j].w); ((u32x2*)orow)[64 * j + lane] = o; }
        float a[8];
#pragma unroll
        for (int g = 0; g < 8; ++g) { float t = 0.f;
#pragma unroll
            for (int j = 0; j < 4; ++j) { const f32x4 w = ((const LAS f32x4*)wg)[g * 256 + 64 * j + lane]; t += (v[j].x * w.x + v[j].y * w.y) + (v[j].z * w.z + v[j].w * w.w); }
            a[g] = t; }
        { const bool hi = lane & 1;
#pragma unroll
          for (int i = 0; i < 4; ++i) { const float keep = hi ? a[i + 4] : a[i], send = hi ? a[i] : a[i + 4]; a[i] = keep + __shfl_xor(send, 1); } }
        { const bool hi = lane & 2;
#pragma unroll
          for (int i = 0; i < 2; ++i) { const float keep = hi ? a[i + 2] : a[i], send = hi ? a[i] : a[i + 2]; a[i] = keep + __shfl_xor(send, 2); } }
        { const bool hi = lane & 4; const float keep = hi ? a[1] : a[0], send = hi ? a[0] : a[1]; a[0] = keep + __shfl_xor(send, 4); }
        float gv = a[0]; gv += __shfl_xor(gv, 8); gv += __shfl_xor(gv, 16); gv += __shfl_xor(gv, 32);
        if (lane < 8) {
            const int gi = 4 * (lane & 1) + 2 * ((lane >> 1) & 1) + ((lane >> 2) & 1);
            float o;
            if (gi < 4) o = sigmoidf_(gv);
            else { const int h = gi - 4; o = -__expf(C.a_log[h]) * softplusf_(gv + C.dt_bias[h]); }
            if (smp) SG[(row - M) * 8 + gi] = o;
            else if (gi < 4) BETA[(size_t)row * 4 + gi] = o; else GG[(size_t)row * 4 + (gi - 4)] = o;
        }
    }
    __syncthreads();
}

template <class ALoad, class Epi>
__device__ __forceinline__ void sgemm32_part(int n0, int kb, int kl, int ldw, const bf16_t* __restrict__ WT, const ALoad& AL, const Epi& E, LAS float* red, int tid) {
    const int lane = tid & 63, wave = tid >> 6, r = lane & 31, h = lane >> 5; const int ks = kl / 8, k0 = kb + wave * ks;
    f32x16 acc;
#pragma unroll
    for (int i = 0; i < 16; ++i) acc[i] = 0.f;
    const bf16_t* wrow = WT + (size_t)(n0 + r) * ldw + k0 + 8 * h;
    for (int k = 0; k < ks; k += 16) { const bf16x8 a = AL(r, k0 + k + 8 * h); const bf16x8 b = *(const bf16x8*)(wrow + k); acc = __builtin_amdgcn_mfma_f32_32x32x16_bf16(a, b, acc, 0, 0, 0); }
#pragma unroll
    for (int i = 0; i < 16; ++i) red[wave * 1024 + i * 64 + lane] = acc[i];
    __syncthreads();
#pragma unroll
    for (int q = 0; q < 2; ++q) { const int e = tid + q * 512; float s = 0.f;
#pragma unroll
        for (int w = 0; w < 8; ++w) s += red[w * 1024 + e];
        const int reg = e >> 6, l = e & 63; E((reg & 3) + 8 * (reg >> 2) + 4 * (l >> 5), n0 + (l & 31), s); }
    __syncthreads();
}
template <class ALoad, class Epi>
__device__ __forceinline__ void sgemm32_item(int n0, int K, const bf16_t* __restrict__ WT, const ALoad& AL, const Epi& E, LAS float* red, int tid) { sgemm32_part(n0, 0, K, K, WT, AL, E, red, tid); }
struct ALoadBf16 { const bf16_t* A; int ld; __device__ __forceinline__ bf16x8 operator()(int row, int k) const { return *(const bf16x8*)(A + (size_t)row * ld + k); } };
struct ALoadF32 { const float* A; int ld;
    __device__ __forceinline__ bf16x8 operator()(int row, int k) const { const f32x4 a = *(const f32x4*)(A + (size_t)row * ld + k), b = *(const f32x4*)(A + (size_t)row * ld + k + 4);
        u32x4 o; o.x = pkbf(a.x, a.y); o.y = pkbf(a.z, a.w); o.z = pkbf(b.x, b.y); o.w = pkbf(b.z, b.w); return __builtin_bit_cast(bf16x8, o); } };

struct EpiIn {
    static constexpr bool PERM = true, AFTER_DRAIN = false;
    bf16_t *PRE, *Z, *QA, *KA, *VA; float* out;
    __device__ __forceinline__ void operator()(const f32x4 (&acc)[2][2][4][2], const pg8::Unit& u, int wr, int wc, int fr, int fq) const {
        const int pn = u.pn, pm = u.pm;
        bf16_t* base; int ldc, coff; float sc = 1.f;
        if (pn < 6) { base = PRE; ldc = CONV_CH; coff = pn * 256; }
        else if (pn < 8) { base = Z; ldc = 512; coff = (pn - 6) * 256; }
        else if (pn < 10) { base = QA; ldc = 512; coff = (pn - 8) * 256; sc = QSCALE; }
        else if (pn < 12) { base = KA; ldc = 512; coff = (pn - 10) * 256; }
        else { base = VA; ldc = 512; coff = (pn - 12) * 256; }
        const int row0 = pm * 256 + wr * 64 + fr, col0 = coff + wc * 32 + 8 * fq;
#pragma unroll
        for (int ai = 0; ai < 2; ++ai)
#pragma unroll
            for (int m = 0; m < 4; ++m) { bf16_t* rowp = base + (size_t)(row0 + ai * 128 + m * 16) * ldc + col0;
#pragma unroll
                for (int bj = 0; bj < 2; ++bj) { const f32x4 v0 = acc[ai][bj][m][0] * sc, v1 = acc[ai][bj][m][1] * sc;
                    u32x4 w; w.x = pkbf(v0[0], v0[1]); w.y = pkbf(v0[2], v0[3]); w.z = pkbf(v1[0], v1[1]); w.w = pkbf(v1[2], v1[3]);
                    *(u32x4*)(rowp + bj * 128) = w; } }
        if (pn >= 10 && (pm & 15) >= 8) {
            float* o = out + (pn < 12 ? O_PWK : O_PWV) + (size_t)((pm >> 4) * WIN + ((pm & 15) - 8) * 256 + wr * 64 + fr) * ATW + col0;
#pragma unroll
            for (int ai = 0; ai < 2; ++ai)
#pragma unroll
                for (int m = 0; m < 4; ++m)
#pragma unroll
                    for (int bj = 0; bj < 2; ++bj) { float* p = o + (size_t)(ai * 128 + m * 16) * ATW + bj * 128; *(f32x4*)p = acc[ai][bj][m][0]; *(f32x4*)(p + 4) = acc[ai][bj][m][1]; }
        }
        if (pn < 6 && (pm & 15) == 15 && wr == 1 && fr >= 13) {
            float* o = out + O_PCONV + (size_t)((pm >> 4) * 3 + (fr - 13)) * CONV_CH + col0;
#pragma unroll
            for (int bj = 0; bj < 2; ++bj) { *(f32x4*)(o + bj * 128) = acc[1][bj][3][0]; *(f32x4*)(o + bj * 128 + 4) = acc[1][bj][3][1]; }
        }
    }
};
__device__ __forceinline__ void p1_inproj(Ctx& C) {
    pg8::Gemm g{WSP(bf16_t, WS_XN), WSP(bf16_t, WS_WIN), M, NIN, D}; pg8::StaticOrder S; S.init(M, NIN, C.G, C.bid);
    EpiIn E{WSP(bf16_t, WS_PRE), WSP(bf16_t, WS_Z), WSP(bf16_t, WS_QA), WSP(bf16_t, WS_KA), WSP(bf16_t, WS_VA), C.out};
    pg8::gemm_phase<EpiIn, pg8::StaticOrder, true, true>(C.lds, g, S, E);
    float* SPROJ = WSP(float, WS_SPROJ);
    const ALoadBf16 AL{WSP(bf16_t, WS_XSN), D};
    auto Ep = [SPROJ](int row, int col, float v) { SPROJ[row * NIN + col] = v; };
    for (int it = C.bid; it < NIN / 32; it += C.G) sgemm32_item(it * 32, D, WSP(bf16_t, WS_WIN), AL, Ep, (LAS float*)C.lds, C.tid);
}

typedef short v4i16_t __attribute__((ext_vector_type(4)));
__device__ __forceinline__ s16x4 tr16(const LAS unsigned char* p) { return __builtin_bit_cast(s16x4, __builtin_amdgcn_ds_read_tr16_b64_v4i16((LAS v4i16_t*)p)); }
typedef float f32x4_t __attribute__((ext_vector_type(4)));

struct AttnItem { int n, h, g, d, rho, B; };
__device__ __forceinline__ AttnItem attn_decode(int item) {
    AttnItem a; const int nh = item / 96, j = item % 96; a.n = nh >> 3; a.h = nh & 7;
    if (j < 32) { a.g = 0; a.d = 1; a.rho = 0; a.B = j; } else if (j < 64) { a.g = 1; a.d = 4; a.rho = (j - 32) >> 3; a.B = (j - 32) & 7; } else { a.g = 2; a.d = 16; a.rho = (j - 64) >> 1; a.B = (j - 64) & 1; }
    return a;
}
struct AttnPre { u32x4 k[4], v[4]; bf16x8 q0, q1; };
__device__ __forceinline__ void attn_prefetch(Ctx& C, const AttnItem& a, AttnPre& P) {
    const bf16_t* QA = WSP(bf16_t, WS_QA); const bf16_t* KA = WSP(bf16_t, WS_KA); const bf16_t* VA = WSP(bf16_t, WS_VA);
    const size_t seq0 = (size_t)a.n * SEQ;
#pragma unroll
    for (int q = 0; q < 4; ++q) { const int ci = C.tid + 512 * q, kl = ci >> 3, c = ci & 7; int sub = 128 * (a.B - 1) + kl; sub = sub < 0 ? 0 : sub;
        const size_t src = (seq0 + a.rho + (size_t)a.d * sub) * 512 + a.h * 64 + c * 8;
        P.k[q] = *(const u32x4*)(KA + src); P.v[q] = *(const u32x4*)(VA + src); }
    const int i = C.lane & 15, G = C.lane >> 4;
    const size_t qrow = seq0 + a.rho + (size_t)a.d * (128 * a.B + 16 * C.wave + i);
    P.q0 = *(const bf16x8*)(QA + qrow * 512 + a.h * 64 + 8 * G); P.q1 = *(const bf16x8*)(QA + qrow * 512 + a.h * 64 + 32 + 8 * G);
}
__device__ __forceinline__ void attn_stage(LAS unsigned char* buf, const AttnPre& P, int tid) {
#pragma unroll
    for (int q = 0; q < 4; ++q) { const int ci = tid + 512 * q, kl = ci >> 3, c = ci & 7;
        *(LAS u32x4*)(buf + kl * 128 + 16 * (c ^ ((kl >> 1) & 7))) = P.k[q];
        *(LAS u32x4*)(buf + 32768 + kl * 128 + 16 * (c ^ (((kl >> 1) & 3) << 1))) = P.v[q]; }
}
__device__ __forceinline__ void attn_compute(Ctx& C, const AttnItem& a, const LAS unsigned char* buf, const bf16x8 qf0, const bf16x8 qf1) {
    bf16_t* OG = WSP(bf16_t, a.g == 0 ? WS_O1 : (a.g == 1 ? WS_O2 : WS_O3)); float* LSE = WSP(float, WS_LSE) + (size_t)a.g * M * 8;
    const int lane = C.lane, w = C.wave, i = lane & 15, G = lane >> 4;
    const LAS unsigned char* Ks = buf; const LAS unsigned char* Vs = buf + 32768;
    const size_t qrow = (size_t)a.n * SEQ + a.rho + (size_t)a.d * (128 * a.B + 16 * w + i);
    const float slope2 = exp2f(-(float)(a.h + 1)) * (float)a.d * LOG2E;
    float be[4];
#pragma unroll
    for (int e = 0; e < 4; ++e) be[e] = -slope2 * (float)(i - 4 * G - e);
    f32x4_t sc[9];
#pragma unroll
    for (int t = 0; t < 9; ++t) { const int kl = 16 * (w + t) + i; const int sw = (kl >> 1) & 7;
        const bf16x8 k0 = *(const LAS bf16x8*)(Ks + kl * 128 + 16 * (G ^ sw)), k1 = *(const LAS bf16x8*)(Ks + kl * 128 + 16 * ((4 + G) ^ sw));
        const float toff = -slope2 * (float)(128 - 16 * t);
        f32x4_t acc = {be[0] + toff, be[1] + toff, be[2] + toff, be[3] + toff};
        acc = __builtin_amdgcn_mfma_f32_16x16x32_bf16(k0, qf0, acc, 0, 0, 0);
        acc = __builtin_amdgcn_mfma_f32_16x16x32_bf16(k1, qf1, acc, 0, 0, 0);
        sc[t] = acc; }
#pragma unroll
    for (int e = 0; e < 4; ++e) { if (4 * G + e < i) sc[0][e] = -INFINITY; if (4 * G + e > i) sc[8][e] = -INFINITY; }
    if (a.B == 0) {
#pragma unroll
        for (int t = 0; t < 8; ++t) if (w + t < 8) sc[t] = (f32x4_t){-INFINITY, -INFINITY, -INFINITY, -INFINITY};
    }
    float mx = -INFINITY;
#pragma unroll
    for (int t = 0; t < 9; ++t) mx = fmaxf(fmaxf(mx, fmaxf(sc[t][0], sc[t][1])), fmaxf(sc[t][2], sc[t][3]));
    mx = fmaxf(mx, __shfl_xor(mx, 16)); mx = fmaxf(mx, __shfl_xor(mx, 32));
    float lsum = 0.f;
#pragma unroll
    for (int t = 0; t < 9; ++t)
#pragma unroll
        for (int e = 0; e < 4; ++e) { const float p = __builtin_amdgcn_exp2f(sc[t][e] - mx); sc[t][e] = p; lsum += p; }
    lsum += __shfl_xor(lsum, 16); lsum += __shfl_xor(lsum, 32);
    f32x4_t o[4];
#pragma unroll
    for (int dt = 0; dt < 4; ++dt) o[dt] = (f32x4_t){0.f, 0.f, 0.f, 0.f};
    const int q4 = (lane & 15) >> 2, p4 = lane & 3;
#pragma unroll
    for (int pp = 0; pp < 5; ++pp) { const int t0 = 2 * pp, t1 = (pp < 4) ? 2 * pp + 1 : 8;
        u32x4 pb; pb.x = pkbf(sc[t0][0], sc[t0][1]); pb.y = pkbf(sc[t0][2], sc[t0][3]);
        if (pp < 4) { pb.z = pkbf(sc[t1][0], sc[t1][1]); pb.w = pkbf(sc[t1][2], sc[t1][3]); } else { pb.z = 0u; pb.w = 0u; }
        const int r0 = 16 * (w + t0) + 4 * G + q4, r1 = 16 * (w + t1) + 4 * G + q4;
        const int s0 = ((r0 >> 1) & 3) << 1, s1 = ((r1 >> 1) & 3) << 1;
#pragma unroll
        for (int dt = 0; dt < 4; ++dt) { const int c = 2 * dt + (p4 >> 1);
            const s16x4 lo = tr16(Vs + r0 * 128 + 16 * (c ^ s0) + 8 * (p4 & 1)), hi = tr16(Vs + r1 * 128 + 16 * (c ^ s1) + 8 * (p4 & 1));
            const bf16x8 vf = {lo[0], lo[1], lo[2], lo[3], hi[0], hi[1], hi[2], hi[3]};
            o[dt] = __builtin_amdgcn_mfma_f32_16x16x32_bf16(vf, __builtin_bit_cast(bf16x8, pb), o[dt], 0, 0, 0); } }
    const float inv = __builtin_amdgcn_rcpf(lsum);
#pragma unroll
    for (int dt = 0; dt < 4; ++dt) { u32x2 ov; ov.x = pkbf(o[dt][0] * inv, o[dt][1] * inv); ov.y = pkbf(o[dt][2] * inv, o[dt][3] * inv);
        *(u32x2*)(OG + qrow * 512 + a.h * 64 + 16 * dt + 4 * G) = ov; }
    if (G == 0) LSE[qrow * 8 + a.h] = mx + __builtin_amdgcn_logf(lsum);
}
__device__ __forceinline__ void attn_phase(Ctx& C, int n_items, int first, int stride) {
    int it = first; if (it >= n_items) return;
    AttnPre P; AttnItem cur = attn_decode(it);
    attn_prefetch(C, cur, P);
    int par = 0;
    for (;;) {
        LAS unsigned char* buf = C.lds + par * 65536;
        attn_stage(buf, P, C.tid);
        const bf16x8 qf0 = P.q0, qf1 = P.q1;
        __syncthreads();
        const int nit = it + stride; AttnItem nxt = cur;
        if (nit < n_items) { nxt = attn_decode(nit); attn_prefetch(C, nxt, P); }
        attn_compute(C, cur, buf, qf0, qf1);
        if (nit >= n_items) break;
        it = nit; cur = nxt; par ^= 1;
    }
    __syncthreads();
}

__device__ __forceinline__ void smp_delta_item(Ctx& C, int item) {
    const int b = item >> 2, hd = item & 3, tid = C.tid;
    const float* SPROJ = WSP(float, WS_SPROJ) + (size_t)b * NIN; const float* SG = WSP(float, WS_SGATE) + b * 8;
    LAS float* L = (LAS float*)C.lds;
    LAS float* yq = L; LAS float* yk = L + 128; LAS float* yv = L + 256; LAS float* red = L + 384; LAS float* pk = L + 512; LAS float* pq = L + 1024; LAS float* ob = L + 1536;
    if (tid < 384) { const int which = tid >> 7, c = tid & 127; const int ch = which * 512 + hd * 128 + c;
        const float s0 = C.st_conv[((size_t)b * 3 + 0) * CONV_CH + ch], s1 = C.st_conv[((size_t)b * 3 + 1) * CONV_CH + ch], s2 = C.st_conv[((size_t)b * 3 + 2) * CONV_CH + ch], xn = SPROJ[ch];
        const float y = s0 * C.conv_w[ch] + s1 * C.conv_w[CONV_CH + ch] + s2 * C.conv_w[2 * CONV_CH + ch] + xn * C.conv_w[3 * CONV_CH + ch];
        L[tid] = siluf(y);
        float* sc = C.out + O_SCONV + (size_t)b * 3 * CONV_CH; sc[ch] = s1; sc[CONV_CH + ch] = s2; sc[2 * CONV_CH + ch] = xn; }
    __syncthreads();
    if (tid < 192) { const int wv = tid >> 6, lane = tid & 63;
        const float a0 = (wv == 1 ? yk : yq)[lane], a1 = (wv == 1 ? yk : yq)[lane + 64], b0 = (wv == 0 ? yq : yk)[lane], b1 = (wv == 0 ? yq : yk)[lane + 64];
        const float s = wave_sum(a0 * b0 + a1 * b1); if (lane == 0) red[wv] = s; }
    __syncthreads();
    const float rq = rsqrtf(red[0] + EPS) * 0.08838834764831845f, rk = rsqrtf(red[1] + EPS);
    const float qk = red[2] * rq * rk;
    const float beta = SG[hd], gdec = __expf(SG[4 + hd]);
    const int v = tid & 127, kq = tid >> 7;
    const float* S0 = C.st_ssm + ((size_t)(b * 4 + hd) * DK + 32 * kq) * DV + v;
    float sreg[32]; float aks = 0.f, aqs = 0.f;
#pragma unroll
    for (int k = 0; k < 32; ++k) { sreg[k] = S0[(size_t)k * DV]; aks += yk[32 * kq + k] * sreg[k]; aqs += yq[32 * kq + k] * sreg[k]; }
    pk[kq * 128 + v] = aks; pq[kq * 128 + v] = aqs;
    __syncthreads();
    const float kS = ((pk[v] + pk[128 + v]) + (pk[256 + v] + pk[384 + v])) * rk, qS = ((pq[v] + pq[128 + v]) + (pq[256 + v] + pq[384 + v])) * rq;
    const float vnew = beta * (yv[v] - gdec * kS);
    const float o = gdec * qS + qk * vnew;
    float* S1 = C.out + O_SSSM + ((size_t)(b * 4 + hd) * DK + 32 * kq) * DV + v;
#pragma unroll
    for (int k = 0; k < 32; ++k) S1[(size_t)k * DV] = gdec * sreg[k] + (yk[32 * kq + k] * rk) * vnew;
    if (kq == 0) ob[v] = o;
    __syncthreads();
    if (tid < 64) { const float s = wave_sum(ob[tid] * ob[tid] + ob[tid + 64] * ob[tid + 64]); if (tid == 0) red[4] = s; }
    __syncthreads();
    if (tid < 128) { const float rs = rsqrtf(red[4] * (1.f / DV) + EPS); const float z = SPROJ[CONV_CH + hd * 128 + tid];
        const float r = ob[tid] * rs * C.dn_norm[tid] * siluf(z);
        WSP(bf16_t, WS_SMIX)[(size_t)b * D + hd * 128 + tid] = (bf16_t)(pkbf(r, 0.f) & 0xffffu); }
    __syncthreads();
}

__device__ __forceinline__ void smp_attn_task(Ctx& C, int task) {
    const int half = task & 1, g = (task >> 1) % 3, bh = task / 6, b = bh >> 3, h = bh & 7, lane = C.lane, sub = lane & 15, grp = lane >> 4;
    const int dil = g == 0 ? 1 : (g == 1 ? 4 : 16), r0 = 1 + 64 * half + grp;
    const f32x4 qq = ((const f32x4*)(WSP(float, WS_SPROJ) + (size_t)b * NIN + 2048 + h * 64))[sub];
    const size_t rowb = ((size_t)b * WIN * ATH + h) * ATD;
    f32x4 kv[16], vv[16];
#pragma unroll
    for (int i = 0; i < 16; ++i) kv[i] = ((const f32x4*)(C.ck + rowb + (size_t)(WIN - (r0 + 4 * i) * dil) * (ATH * ATD)))[sub];
#pragma unroll
    for (int i = 0; i < 16; ++i) vv[i] = ((const f32x4*)(C.cv + rowb + (size_t)(WIN - (r0 + 4 * i) * dil) * (ATH * ATD)))[sub];
    const float slope = exp2f(-(float)(h + 1)) * LOG2E;
    float sc[16], m = -3.0e38f;
#pragma unroll
    for (int i = 0; i < 16; ++i) { float d = (qq.x * kv[i].x + qq.y * kv[i].y) + (qq.z * kv[i].z + qq.w * kv[i].w);
        d += __shfl_xor(d, 1); d += __shfl_xor(d, 2); d += __shfl_xor(d, 4); d += __shfl_xor(d, 8);
        sc[i] = d * QSCALE - slope * (float)((r0 + 4 * i) * dil); m = fmaxf(m, sc[i]); }
    m = fmaxf(m, __shfl_xor(m, 16)); m = fmaxf(m, __shfl_xor(m, 32));
    float l = 0.f; f32x4 o = {0.f, 0.f, 0.f, 0.f};
#pragma unroll
    for (int i = 0; i < 16; ++i) { const float p = exp2f(sc[i] - m); l += p; o += vv[i] * p; }
    l += __shfl_xor(l, 16); l += __shfl_xor(l, 32);
    o.x += __shfl_xor(o.x, 16); o.y += __shfl_xor(o.y, 16); o.z += __shfl_xor(o.z, 16); o.w += __shfl_xor(o.w, 16);
    o.x += __shfl_xor(o.x, 32); o.y += __shfl_xor(o.y, 32); o.z += __shfl_xor(o.z, 32); o.w += __shfl_xor(o.w, 32);
    float* P = WSP(float, WS_SATT) + (size_t)task * 66;
    if (grp == 0) { P[2 + 4 * sub] = o.x; P[3 + 4 * sub] = o.y; P[4 + 4 * sub] = o.z; P[5 + 4 * sub] = o.w; }
    if (lane == 0) { P[0] = m; P[1] = l; }
}
__device__ __forceinline__ void smp_attn_merge(Ctx& C, int bh) {
    const int b = bh >> 3, h = bh & 7, lane = C.lane;
    const float* SPROJ = WSP(float, WS_SPROJ) + (size_t)b * NIN;
    const float s0 = wave_sum(SPROJ[2048 + h * 64 + lane] * SPROJ[2560 + h * 64 + lane]) * QSCALE;
    const float* P = WSP(float, WS_SATT) + (size_t)bh * 6 * 66;
    float mx = s0;
#pragma unroll
    for (int t = 0; t < 6; ++t) mx = fmaxf(mx, P[t * 66]);
    const float w0 = 3.f * exp2f(s0 - mx);
    float l = w0, o = w0 * SPROJ[3072 + h * 64 + lane];
#pragma unroll
    for (int t = 0; t < 6; ++t) { const float w = exp2f(P[t * 66] - mx); l += w * P[t * 66 + 1]; o += w * P[t * 66 + 2 + lane]; }
    WSP(bf16_t, WS_SMIX)[(size_t)b * D + 512 + h * 64 + lane] = (bf16_t)(pkbf(o / l, 0.f) & 0xffffu);
}

__device__ __forceinline__ void smp_window_copy(Ctx& C, int part, int nparts) {
    const float* SPROJ = WSP(float, WS_SPROJ);
    const size_t total = (size_t)2 * SB * WIN * 128;
    for (size_t blk = (size_t)part * (8 * NTHREADS); blk < total; blk += (size_t)nparts * (8 * NTHREADS)) {
        f32x4 val[8];
#pragma unroll
        for (int u = 0; u < 8; ++u) { const size_t idx = blk + u * NTHREADS + C.tid;
            const int c4 = (int)(idx & 127); const size_t rowi = idx >> 7; const int jrow = (int)(rowi & (WIN - 1)); const int b = (int)((rowi >> 11) & 31); const int kv = (int)(rowi >> 16);
            if (jrow < WIN - 1) val[u] = __builtin_nontemporal_load((const f32x4*)(kv ? C.cv : C.ck) + ((size_t)b * WIN + jrow + 1) * 128 + c4);
            else val[u] = *(const f32x4*)(SPROJ + (size_t)b * NIN + (kv ? 3072 : 2560) + 4 * c4); }
#pragma unroll
        for (int u = 0; u < 8; ++u) { const size_t idx = blk + u * NTHREADS + C.tid;
            const int c4 = (int)(idx & 127); const size_t rowi = idx >> 7; const int jrow = (int)(rowi & (WIN - 1)); const int b = (int)((rowi >> 11) & 31); const int kv = (int)(rowi >> 16);
            __builtin_nontemporal_store(val[u], (f32x4*)(C.out + (kv ? O_SWV : O_SWK)) + ((size_t)b * WIN + jrow) * 128 + c4); }
    }
}

constexpr int PL_KN = 0, PL_VV = 33792, PL_QB = 67584, PL_MM = 84992, PL_WB = 102400, PL_SM = 119808, PL_TD = 121856;
__device__ __forceinline__ LAS unsigned char* opaque_lds(LAS unsigned char* p) { unsigned v = (unsigned)(uintptr_t)p; asm volatile("" : "+v"(v)); return (LAS unsigned char*)(uintptr_t)v; }
__device__ __forceinline__ bf16x8 ld_f32x8_as_bf16(const LAS float* p) { const f32x4 a = *(const LAS f32x4*)p, b = *(const LAS f32x4*)(p + 4);
    u32x4 o; o.x = pkbf(a.x, a.y); o.y = pkbf(a.z, a.w); o.z = pkbf(b.x, b.y); o.w = pkbf(b.z, b.w); return __builtin_bit_cast(bf16x8, o); }

struct PrepPre { u32x4 r[11]; float be, g; };
__device__ __forceinline__ void prep_prefetch(Ctx& C, int item, PrepPre& P) {
    const int c = item & 63, hd = (item >> 6) & 3, n = item >> 8, tid = C.tid; const size_t seq0 = (size_t)n * SEQ;
    if (tid < 384) { const int cg = tid % 48, seg = tid / 48, which = cg >> 4, c8 = cg & 15; const int chb = which * 512 + hd * 128 + 8 * c8;
        const bf16_t* PRE = WSP(bf16_t, WS_PRE);
#pragma unroll
        for (int rr = 0; rr < 11; ++rr) { const int t = 64 * c + 8 * seg + rr - 3; u32x4 v = {0u, 0u, 0u, 0u};
            if (t >= 0) v = *(const u32x4*)(PRE + (seq0 + t) * CONV_CH + chb);
            P.r[rr] = v; }
    } else if (C.wave == 6) { const size_t row = seq0 + 64 * c + C.lane; P.be = WSP(float, WS_BETA)[row * 4 + hd]; P.g = WSP(float, WS_GG)[row * 4 + hd]; }
}
__device__ __forceinline__ void gdn_prep_item(Ctx& C, int item, PrepPre& P, int next_item) {
    const int c = item & 63, hd = (item >> 6) & 3, n = item >> 8;
    const int tid = C.tid, lane = C.lane, wave = C.wave;
    const size_t seq0 = (size_t)n * SEQ;
    LAS unsigned char* L0 = opaque_lds(C.lds);
    LAS float* KN = (LAS float*)(L0 + PL_KN); LAS float* VV = (LAS float*)(L0 + PL_VV); LAS bf16_t* QB = (LAS bf16_t*)(L0 + PL_QB);
    LAS float* MM = (LAS float*)(L0 + PL_MM); LAS bf16_t* WB = (LAS bf16_t*)(L0 + PL_WB); LAS float* SM = (LAS float*)(L0 + PL_SM);
    LAS float* s_beta = SM; LAS float* s_gc = SM + 64; LAS float* s_egc = SM + 128; LAS float* s_ekd = SM + 192; LAS float* s_bw = SM + 256; LAS float* TD = (LAS float*)(L0 + PL_TD);
    unsigned char* img = C.ws + WS_GDN + (size_t)item * GDN_CHUNK_BYTES;
    if (tid < 384) {
        const int cg = tid % 48, seg = tid / 48, which = cg >> 4, c8 = cg & 15; const int chb = which * 512 + hd * 128 + 8 * c8;
        float cw[4][8];
#pragma unroll
        for (int i = 0; i < 4; ++i) { const f32x4 a = *(const f32x4*)(C.conv_w + i * CONV_CH + chb), b = *(const f32x4*)(C.conv_w + i * CONV_CH + chb + 4);
            cw[i][0] = a.x; cw[i][1] = a.y; cw[i][2] = a.z; cw[i][3] = a.w; cw[i][4] = b.x; cw[i][5] = b.y; cw[i][6] = b.z; cw[i][7] = b.w; }
        float xr[11][8];
#pragma unroll
        for (int rr = 0; rr < 11; ++rr) { const u32x4 v = P.r[rr];
            xr[rr][0] = bflo(v.x); xr[rr][1] = bfhi(v.x); xr[rr][2] = bflo(v.y); xr[rr][3] = bfhi(v.y); xr[rr][4] = bflo(v.z); xr[rr][5] = bfhi(v.z); xr[rr][6] = bflo(v.w); xr[rr][7] = bfhi(v.w); }
#pragma unroll
        for (int tt = 0; tt < 8; ++tt) { float y[8]; float ss = 0.f;
#pragma unroll
            for (int e = 0; e < 8; ++e) { const float a = (xr[tt][e] * cw[0][e] + xr[tt + 1][e] * cw[1][e]) + (xr[tt + 2][e] * cw[2][e] + xr[tt + 3][e] * cw[3][e]); y[e] = siluf(a); ss += y[e] * y[e]; }
            ss += __shfl_xor(ss, 1); ss += __shfl_xor(ss, 2); ss += __shfl_xor(ss, 4); ss += __shfl_xor(ss, 8);
            const int row = 8 * seg + tt;
            if (which == 0) { const float sc = rsqrtf(ss + EPS) * 0.08838834764831845f;
                u32x4 o; o.x = pkbf(y[0] * sc, y[1] * sc); o.y = pkbf(y[2] * sc, y[3] * sc); o.z = pkbf(y[4] * sc, y[5] * sc); o.w = pkbf(y[6] * sc, y[7] * sc);
                *(LAS u32x4*)(QB + row * 136 + 8 * c8) = o; }
            else { const float sc = which == 1 ? rsqrtf(ss + EPS) : 1.f; LAS float* dst = (which == 1 ? KN : VV) + row * 132 + 8 * c8;
                *(LAS f32x4*)dst = (f32x4){y[0] * sc, y[1] * sc, y[2] * sc, y[3] * sc}; *(LAS f32x4*)(dst + 4) = (f32x4){y[4] * sc, y[5] * sc, y[6] * sc, y[7] * sc}; } }
    } else if (wave == 6) {
        const float be = P.be; float x = P.g;
#pragma unroll
        for (int off = 1; off < 64; off <<= 1) { const float t = __shfl_up(x, off); if (lane >= off) x += t; }
        const float gl = __shfl(x, 63);
        s_beta[lane] = be; s_gc[lane] = x; s_egc[lane] = __expf(x); s_ekd[lane] = __expf(gl - x); s_bw[lane] = be * __expf(x);
        if (lane == 0) WSP(float, WS_EGL)[item] = __expf(gl);
    }
    __syncthreads();
    if (next_item >= 0) prep_prefetch(C, next_item, P);
    if (wave < 6) {
        const int kind = wave / 3, tsel = wave % 3; const int it = tsel == 1 ? 0 : 1, jt = tsel == 2 ? 1 : 0;
        const int r = lane & 31, hh = lane >> 5;
        f32x16 acc;
#pragma unroll
        for (int e = 0; e < 16; ++e) acc[e] = 0.f;
#pragma unroll
        for (int ks = 0; ks < 8; ++ks) { const bf16x8 a = ld_f32x8_as_bf16(KN + (32 * jt + r) * 132 + 16 * ks + 8 * hh);
            bf16x8 b; if (kind == 0) b = ld_f32x8_as_bf16(KN + (32 * it + r) * 132 + 16 * ks + 8 * hh); else b = *(const LAS bf16x8*)(QB + (32 * it + r) * 136 + 16 * ks + 8 * hh);
            acc = __builtin_amdgcn_mfma_f32_32x32x16_bf16(a, b, acc, 0, 0, 0); }
        const int i = 32 * it + r; const float gci = s_gc[i], nbi = -s_beta[i];
        float vals[16];
#pragma unroll
        for (int e = 0; e < 16; ++e) { const int j = 32 * jt + (e & 3) + 8 * (e >> 2) + 4 * hh; const float dec = __expf(gci - s_gc[j]);
            vals[e] = kind == 0 ? ((i > j) ? nbi * acc[e] * dec : 0.f) : ((i >= j) ? acc[e] * dec : 0.f); }
        if (kind == 0) {
#pragma unroll
            for (int a4 = 0; a4 < 4; ++a4) *(LAS f32x4*)(MM + i * 68 + 32 * jt + 8 * a4 + 4 * hh) = (f32x4){vals[4 * a4], vals[4 * a4 + 1], vals[4 * a4 + 2], vals[4 * a4 + 3]};
        } else {
#pragma unroll
            for (int s = 0; s < 2; ++s) { u32x4 o; o.x = pkbf(vals[8 * s], vals[8 * s + 1]); o.y = pkbf(vals[8 * s + 2], vals[8 * s + 3]); o.z = pkbf(vals[8 * s + 4], vals[8 * s + 5]); o.w = pkbf(vals[8 * s + 6], vals[8 * s + 7]);
                *(u32x4*)(img + GI_QK + ((it * 4 + 2 * jt + s) * 64 + lane) * 16) = o; }
        }
    } else {
        const int t2 = tid - 384;
#pragma unroll
        for (int q = 0; q < 8; ++q) { const int f = t2 + 128 * q; const int lf = f & 63, kk = (f >> 6) & 7, rt = f >> 9; const int r = lf & 31, hh = lf >> 5;
            const int i = 32 * rt + r, cb = 32 * (kk >> 1) + 16 * (kk & 1) + 4 * hh; const float e = s_egc[i];
            const u32x2 a = *(const LAS u32x2*)(QB + i * 136 + cb), b = *(const LAS u32x2*)(QB + i * 136 + cb + 8);
            u32x4 o; o.x = pkbf(bflo(a.x) * e, bfhi(a.x) * e); o.y = pkbf(bflo(a.y) * e, bfhi(a.y) * e); o.z = pkbf(bflo(b.x) * e, bfhi(b.x) * e); o.w = pkbf(bflo(b.y) * e, bfhi(b.y) * e);
            *(u32x4*)(img + GI_QG + f * 16) = o; }
    }
    __syncthreads();
    if (wave == 0) {
        const int d = lane >> 4, j = lane & 15; const LAS float* Md = MM + (16 * d) * 68 + 16 * d; float t[16];
#pragma unroll
        for (int i = 0; i < 16; ++i) { float a = (i == j) ? 1.f : 0.f;
#pragma unroll
            for (int k = 0; k < i; ++k) a += Md[i * 68 + k] * t[k];
            t[i] = a; TD[(d * 16 + i) * 16 + j] = a; }
    } else if (wave >= 4) {
        const int t2 = tid - 256;
#pragma unroll
        for (int q = 0; q < 4; ++q) { const int f = t2 + 256 * q; const int lf = f & 63, kk = (f >> 6) & 3, rt = f >> 8; const int r = lf & 31, hh = lf >> 5;
            const int cc = 32 * rt + r, tb = 32 * (kk >> 1) + 16 * (kk & 1) + 4 * hh; float v[8];
#pragma unroll
            for (int jj = 0; jj < 8; ++jj) { const int tk = tb + 8 * (jj >> 2) + (jj & 3); v[jj] = KN[tk * 132 + cc] * s_ekd[tk]; }
            u32x4 o; o.x = pkbf(v[0], v[1]); o.y = pkbf(v[2], v[3]); o.z = pkbf(v[4], v[5]); o.w = pkbf(v[6], v[7]);
            *(u32x4*)(img + GI_KD + f * 16) = o; }
    }
    __syncthreads();
    {
        const int i16 = lane & 15, G = lane >> 4; const bool isw = wave >= 4;
        const LAS float* src = (isw ? KN : VV) + 32 * (wave & 3) + i16; const LAS float* scl = isw ? s_bw : s_beta;
        f32x4 X[4][2];
#pragma unroll
        for (int bi = 0; bi < 4; ++bi) {
#pragma unroll
            for (int tl = 0; tl < 2; ++tl)
#pragma unroll
                for (int e = 0; e < 4; ++e) { const int row = 16 * bi + 4 * G + e; X[bi][tl][e] = scl[row] * src[row * 132 + 16 * tl]; }
#pragma unroll
            for (int bj = 0; bj < bi; ++bj) { const f32x4 a = *(const LAS f32x4*)(MM + (16 * bi + i16) * 68 + 16 * bj + 4 * G);
#pragma unroll
                for (int s4 = 0; s4 < 4; ++s4)
#pragma unroll
                    for (int tl = 0; tl < 2; ++tl) X[bi][tl] = __builtin_amdgcn_mfma_f32_16x16x4f32(a[s4], X[bj][tl][s4], X[bi][tl], 0, 0, 0); }
            const f32x4 td = *(const LAS f32x4*)(TD + (bi * 16 + i16) * 16 + 4 * G);
            f32x4 y0 = {0.f, 0.f, 0.f, 0.f}, y1 = {0.f, 0.f, 0.f, 0.f};
#pragma unroll
            for (int s4 = 0; s4 < 4; ++s4) { y0 = __builtin_amdgcn_mfma_f32_16x16x4f32(td[s4], X[bi][0][s4], y0, 0, 0, 0); y1 = __builtin_amdgcn_mfma_f32_16x16x4f32(td[s4], X[bi][1][s4], y1, 0, 0, 0); }
            X[bi][0] = y0; X[bi][1] = y1;
        }
        if (!isw) {
#pragma unroll
            for (int bi = 0; bi < 4; ++bi)
#pragma unroll
                for (int tl = 0; tl < 2; ++tl) { u32x2 o; o.x = pkbf(X[bi][tl][0], X[bi][tl][1]); o.y = pkbf(X[bi][tl][2], X[bi][tl][3]);
                    *(u32x2*)(img + GI_U + (((wave * 2 + (bi >> 1)) * 64) + 32 * (G & 1) + 16 * tl + i16) * 32 + 8 * (2 * (bi & 1) + (G >> 1))) = o; }
        } else {
#pragma unroll
            for (int bi = 0; bi < 4; ++bi)
#pragma unroll
                for (int tl = 0; tl < 2; ++tl)
#pragma unroll
                    for (int e = 0; e < 4; ++e) WB[(16 * bi + 4 * G + e) * 136 + 32 * (wave - 4) + 16 * tl + i16] = (bf16_t)(pkbf(-X[bi][tl][e], 0.f) & 0xffffu);
        }
    }
    __syncthreads();
#pragma unroll
    for (int q = 0; q < 2; ++q) { const int f = tid + 512 * q; const int lf = f & 63, kk = (f >> 6) & 7, rt = f >> 9; const int r = lf & 31, hh = lf >> 5;
        const int i = 32 * rt + r, cb = 32 * (kk >> 1) + 16 * (kk & 1) + 4 * hh;
        const u32x2 a = *(const LAS u32x2*)(WB + i * 136 + cb), b = *(const LAS u32x2*)(WB + i * 136 + cb + 8);
        *(u32x4*)(img + GI_NW + f * 16) = (u32x4){a.x, a.y, b.x, b.y}; }
}

constexpr int SC_BUF = 57344;
__device__ __forceinline__ bf16x8 pack8(const f32x16& a, int s) {
    u32x4 o; o.x = pkbf(a[8 * s + 0], a[8 * s + 1]); o.y = pkbf(a[8 * s + 2], a[8 * s + 3]); o.z = pkbf(a[8 * s + 4], a[8 * s + 5]); o.w = pkbf(a[8 * s + 6], a[8 * s + 7]); return __builtin_bit_cast(bf16x8, o); }
constexpr int SC_SLOTA = 32768, SC_SLOTB = 38912, SC_B0 = 2 * SC_SLOTA, SC_STG = SC_B0 + 2 * SC_SLOTB, SC_END = SC_STG + 16384;
__device__ __forceinline__ void gdn_scan_item(Ctx& C, int item) {
    const int n = item >> 2, hd = item & 3, lane = C.lane, wave = C.wave, w4 = wave - 4;
    const unsigned char* base = C.ws + WS_GDN + (size_t)item * 64 * GDN_CHUNK_BYTES;
    const float* EGL = WSP(float, WS_EGL) + item * 64;
    bf16_t* ORAW = WSP(bf16_t, WS_ORAW);
    LAS unsigned char* L0 = opaque_lds(C.lds);
#define SC_BAR() do { asm volatile("s_waitcnt lgkmcnt(0)" ::: "memory"); __builtin_amdgcn_s_barrier(); asm volatile("" ::: "memory"); } while (0)
#define SC_PIN() __builtin_amdgcn_sched_barrier(0)
    if (wave < 4) {
      f32x16 S[4];
#pragma unroll
      for (int a = 0; a < 4; ++a) {
#pragma unroll
        for (int e = 0; e < 16; ++e) S[a][e] = 0.f; }
      const unsigned eglv = __float_as_uint(EGL[lane]);
      SC_BAR();
      for (int c = 0; c < NCH; ++c) {
        int ln = lane; asm volatile("" : "+v"(ln));
        const int lr = ln & 31, lh = ln >> 5;
        const LAS unsigned char* sa = L0 + (c & 1) * SC_SLOTA; const LAS unsigned char* sbp = L0 + SC_B0 + (c & 1) * SC_SLOTB;
        const LAS unsigned char* fNW = sa + ln * 16; const LAS unsigned char* fU = sa + 16384 + ((wave * 2) * 64 + ln) * 32;
        const LAS unsigned char* fQG = sbp + ln * 16; const LAS unsigned char* fQK = sbp + 16384 + ln * 16; const LAS unsigned char* fKD = sbp + 22528 + ln * 16;
        bf16x8 G0[8], G1[8];
#define SC_RD(G, ptr, i0) do { _Pragma("unroll") for (int i_ = 0; i_ < 8; ++i_) G[i_] = *(const LAS bf16x8*)((ptr) + ((i0) + i_) * 1024); } while (0)
#define SC_RD_H(G, ptr, h) do { _Pragma("unroll") for (int i_ = 0; i_ < 4; ++i_) { G[i_] = *(const LAS bf16x8*)((ptr) + (4 * (h) + i_) * 1024); G[4 + i_] = *(const LAS bf16x8*)((ptr) + (8 + 4 * (h) + i_) * 1024); } } while (0)
        u32x4 uu[2][2];
#pragma unroll
        for (int rt = 0; rt < 2; ++rt) { uu[rt][0] = *(const LAS u32x4*)(fU + rt * 2048); uu[rt][1] = *(const LAS u32x4*)(fU + rt * 2048 + 16); }
        SC_RD_H(G0, fNW, 0); SC_RD_H(G1, fNW, 1); SC_PIN();
        f32x16 Y[2];
#pragma unroll
        for (int rt = 0; rt < 2; ++rt)
#pragma unroll
            for (int q = 0; q < 2; ++q) { const u32x4 u = uu[rt][q];
                Y[rt][8 * q + 0] = bflo(u.x); Y[rt][8 * q + 1] = bfhi(u.x); Y[rt][8 * q + 2] = bflo(u.y); Y[rt][8 * q + 3] = bfhi(u.y);
                Y[rt][8 * q + 4] = bflo(u.z); Y[rt][8 * q + 5] = bfhi(u.z); Y[rt][8 * q + 6] = bflo(u.w); Y[rt][8 * q + 7] = bfhi(u.w); }
#pragma unroll
        for (int k4 = 0; k4 < 4; ++k4) { const bf16x8 sb = pack8(S[k4 >> 1], k4 & 1);
            Y[0] = __builtin_amdgcn_mfma_f32_32x32x16_bf16(G0[k4], sb, Y[0], 0, 0, 0); Y[1] = __builtin_amdgcn_mfma_f32_32x32x16_bf16(G0[4 + k4], sb, Y[1], 0, 0, 0); }
        SC_PIN(); SC_RD_H(G0, fQG, 0); SC_PIN();
#pragma unroll
        for (int k4 = 0; k4 < 4; ++k4) { const bf16x8 sb = pack8(S[2 + (k4 >> 1)], k4 & 1);
            Y[0] = __builtin_amdgcn_mfma_f32_32x32x16_bf16(G1[k4], sb, Y[0], 0, 0, 0); Y[1] = __builtin_amdgcn_mfma_f32_32x32x16_bf16(G1[4 + k4], sb, Y[1], 0, 0, 0); }
        SC_PIN(); SC_RD_H(G1, fQG, 1); SC_PIN();
        f32x16 O[2];
#pragma unroll
        for (int rt = 0; rt < 2; ++rt)
#pragma unroll
            for (int e = 0; e < 16; ++e) O[rt][e] = 0.f;
#pragma unroll
        for (int k4 = 0; k4 < 4; ++k4) { const bf16x8 sb = pack8(S[k4 >> 1], k4 & 1);
            O[0] = __builtin_amdgcn_mfma_f32_32x32x16_bf16(G0[k4], sb, O[0], 0, 0, 0); O[1] = __builtin_amdgcn_mfma_f32_32x32x16_bf16(G0[4 + k4], sb, O[1], 0, 0, 0); }
        SC_PIN();
#pragma unroll
        for (int i = 0; i < 6; ++i) G0[i] = *(const LAS bf16x8*)(fQK + i * 1024);
        SC_PIN();
#pragma unroll
        for (int k4 = 0; k4 < 4; ++k4) { const bf16x8 sb = pack8(S[2 + (k4 >> 1)], k4 & 1);
            O[0] = __builtin_amdgcn_mfma_f32_32x32x16_bf16(G1[k4], sb, O[0], 0, 0, 0); O[1] = __builtin_amdgcn_mfma_f32_32x32x16_bf16(G1[4 + k4], sb, O[1], 0, 0, 0); }
        SC_PIN(); SC_RD(G1, fKD, 0); SC_PIN();
        bf16x8 Yb[2][2];
#pragma unroll
        for (int yt = 0; yt < 2; ++yt) { Yb[yt][0] = pack8(Y[yt], 0); Yb[yt][1] = pack8(Y[yt], 1); }
        O[0] = __builtin_amdgcn_mfma_f32_32x32x16_bf16(G0[0], Yb[0][0], O[0], 0, 0, 0); O[0] = __builtin_amdgcn_mfma_f32_32x32x16_bf16(G0[1], Yb[0][1], O[0], 0, 0, 0);
#pragma unroll
        for (int kk = 0; kk < 4; ++kk) O[1] = __builtin_amdgcn_mfma_f32_32x32x16_bf16(G0[2 + kk], Yb[kk >> 1][kk & 1], O[1], 0, 0, 0);
        SC_PIN(); SC_RD(G0, fKD, 8); SC_PIN();
        const float egl = __uint_as_float(__builtin_amdgcn_readlane(eglv, c));
#pragma unroll
        for (int a = 0; a < 2; ++a) {
#pragma unroll
            for (int e = 0; e < 16; ++e) S[a][e] *= egl;
#pragma unroll
            for (int kk = 0; kk < 4; ++kk) S[a] = __builtin_amdgcn_mfma_f32_32x32x16_bf16(G1[a * 4 + kk], Yb[kk >> 1][kk & 1], S[a], 0, 0, 0); }
        { LAS bf16_t* stg = (LAS bf16_t*)(L0 + SC_STG) + (4 * lh) * 128 + wave * 32 + lr;
#pragma unroll
          for (int rt = 0; rt < 2; ++rt)
#pragma unroll
            for (int e = 0; e < 16; ++e) stg[(32 * rt + (e & 3) + 8 * (e >> 2)) * 128] = (bf16_t)(pkbf(O[rt][e], 0.f) & 0xffffu); }
        SC_BAR();
#pragma unroll
        for (int a = 2; a < 4; ++a) {
#pragma unroll
            for (int e = 0; e < 16; ++e) S[a][e] *= egl;
#pragma unroll
            for (int kk = 0; kk < 4; ++kk) S[a] = __builtin_amdgcn_mfma_f32_32x32x16_bf16(G0[(a - 2) * 4 + kk], Yb[kk >> 1][kk & 1], S[a], 0, 0, 0); }
        SC_BAR();
#undef SC_RD
#undef SC_RD_H
      }
      { const int r = lane & 31, hh = lane >> 5;
        float* ps = C.out + O_PSSM + ((size_t)item * DK + 4 * hh) * DV + wave * 32 + r;
#pragma unroll
        for (int a = 0; a < 4; ++a)
#pragma unroll
            for (int e = 0; e < 16; ++e) ps[(size_t)(32 * a + (e & 3) + 8 * (e >> 2)) * DV] = S[a][e]; }
    } else {
      u32x4 RA0[8], RB0[10], RA1[8], RB1[10];
#define SC_LD_A(RA, cidx, LN) do { const int cc_ = (cidx) < NCH ? (cidx) : NCH - 1; const unsigned char* g_ = base + (size_t)cc_ * GDN_CHUNK_BYTES + (LN) * 16 + w4 * 1024; \
        _Pragma("unroll") for (int q_ = 0; q_ < 4; ++q_) RA[q_] = *(const u32x4*)(g_ + GI_NW + q_ * 4096); \
        _Pragma("unroll") for (int q_ = 0; q_ < 4; ++q_) RA[4 + q_] = *(const u32x4*)(g_ + GI_U + q_ * 4096); } while (0)
#define SC_LD_B(RB, cidx, LN) do { const int cc_ = (cidx) < NCH ? (cidx) : NCH - 1; const unsigned char* g_ = base + (size_t)cc_ * GDN_CHUNK_BYTES + (LN) * 16 + w4 * 1024; \
        _Pragma("unroll") for (int q_ = 0; q_ < 10; ++q_) RB[q_] = *(const u32x4*)(g_ + GI_QG + q_ * 4096); } while (0)
#define SC_ST_A(RA, slot, LN) do { LAS unsigned char* la_ = L0 + (slot) * SC_SLOTA + w4 * 1024 + (LN) * 16; \
        _Pragma("unroll") for (int q_ = 0; q_ < 4; ++q_) *(LAS u32x4*)(la_ + q_ * 4096) = RA[q_]; \
        _Pragma("unroll") for (int q_ = 0; q_ < 4; ++q_) *(LAS u32x4*)(la_ + 16384 + q_ * 4096) = RA[4 + q_]; } while (0)
#define SC_ST_B(RB, slot, LN) do { LAS unsigned char* lb_ = L0 + SC_B0 + (slot) * SC_SLOTB + w4 * 1024 + (LN) * 16; \
        _Pragma("unroll") for (int q_ = 0; q_ < 10; ++q_) { if (q_ < 4) *(LAS u32x4*)(lb_ + q_ * 4096) = RB[q_]; else if (q_ == 4) { if (w4 < 2) *(LAS u32x4*)(lb_ + q_ * 4096) = RB[q_]; } else *(LAS u32x4*)(lb_ + q_ * 4096 - 2048) = RB[q_]; } } while (0)
#define SC_OUT(cidx, LN) do { const LAS unsigned char* st_ = L0 + SC_STG + w4 * 4096 + (LN) * 16; \
        bf16_t* op_ = ORAW + ((size_t)n * SEQ + 64 * (cidx) + 16 * w4 + ((LN) >> 4)) * 512 + hd * 128 + ((LN) & 15) * 8; \
        _Pragma("unroll") for (int q_ = 0; q_ < 4; ++q_) *(u32x4*)(op_ + (size_t)(4 * q_) * 512) = *(const LAS u32x4*)(st_ + q_ * 1024); } while (0)
      SC_LD_A(RA0, 0, lane); SC_LD_B(RB0, 0, lane); SC_LD_A(RA1, 1, lane); SC_LD_B(RB1, 1, lane);
      SC_ST_A(RA0, 0, lane); SC_ST_B(RB0, 0, lane); SC_ST_A(RA1, 1, lane);
      SC_LD_A(RA0, 2, lane); SC_LD_B(RB0, 2, lane); SC_LD_A(RA1, 3, lane);
      SC_BAR();
      for (int c2 = 0; c2 < NCH; c2 += 2) {
        int ln = lane; asm volatile("" : "+v"(ln));
        SC_BAR(); SC_OUT(c2, ln); SC_ST_B(RB1, 1, ln); SC_LD_B(RB1, c2 + 3, ln);
        SC_BAR(); SC_ST_A(RA0, 0, ln); SC_LD_A(RA0, c2 + 4, ln);
        SC_BAR(); SC_OUT(c2 + 1, ln); SC_ST_B(RB0, 0, ln); SC_LD_B(RB0, c2 + 4, ln);
        SC_BAR(); SC_ST_A(RA1, 1, ln); SC_LD_A(RA1, c2 + 5, ln);
      }
#undef SC_LD_A
#undef SC_LD_B
#undef SC_ST_A
#undef SC_ST_B
#undef SC_OUT
    }
    VM_WAIT();
    __syncthreads();
#undef SC_BAR
#undef SC_PIN
}

__device__ __forceinline__ void p2_mixprep(Ctx& C) {
    constexpr int N_PREP = NB * NHD * NCH, N_SD = SB * NHD, N_SA = SB * ATH * 6 / NWAVES;
    for (int it = C.bid; it < N_SD; it += C.G) smp_delta_item(C, it);
    const int a0 = C.G - 1 - C.bid, slot = a0 < N_SA ? (a0 & 7) : -1;
    for (int it = a0 + C.G; it < N_SA; it += C.G) smp_attn_task(C, it * NWAVES + C.wave);
    if (slot == 0) smp_attn_task(C, a0 * NWAVES + C.wave);
    __syncthreads();
    { PrepPre P; int it = C.bid;
      if (it < N_PREP) prep_prefetch(C, it, P);
      if (slot > 0) {
          for (int k = 0; it < N_PREP && k < slot; it += C.G, ++k) gdn_prep_item(C, it, P, (k + 1 < slot && it + C.G < N_PREP) ? it + C.G : -1);
          smp_attn_task(C, a0 * NWAVES + C.wave);
          if (it < N_PREP) prep_prefetch(C, it, P); }
      for (; it < N_PREP; it += C.G) gdn_prep_item(C, it, P, it + C.G < N_PREP ? it + C.G : -1); }
}
__device__ __forceinline__ void p3_scan(Ctx& C) {
    constexpr int N_SCAN = NB * NHD, N_ATT = NB * ATH * 96;
    if (C.bid < N_SCAN) gdn_scan_item(C, C.bid);
    else { const int part = C.bid - N_SCAN, np = C.G - N_SCAN;
        if ((part >> 3) & 1) { attn_phase(C, N_ATT, part, np); late_weight_copies(C, part, np); smp_window_copy(C, part, np); }
        else { late_weight_copies(C, part, np); smp_window_copy(C, part, np); attn_phase(C, N_ATT, part, np); } }
}

__device__ __forceinline__ void p4_combine(Ctx& C) {
    const int gw = C.bid * NWAVES + C.wave, NGW = C.G * NWAVES, lane = C.lane;
    const bf16_t* ORAW = WSP(bf16_t, WS_ORAW); const bf16_t* Z = WSP(bf16_t, WS_Z);
    const bf16_t* O1 = WSP(bf16_t, WS_O1); const bf16_t* O2 = WSP(bf16_t, WS_O2); const bf16_t* O3 = WSP(bf16_t, WS_O3);
    float nw[8];
#pragma unroll
    for (int e = 0; e < 8; ++e) nw[e] = C.dn_norm[(8 * lane + e) & 127];
    const float* LSE = WSP(float, WS_LSE); bf16_t* MIX = WSP(bf16_t, WS_MIX);
    for (int bh = gw; bh < SB * ATH; bh += NGW) smp_attn_merge(C, bh);
    for (int row = gw; row < M; row += NGW) {
        { const u32x4 ov = *(const u32x4*)(ORAW + (size_t)row * 512 + 8 * lane), zv = *(const u32x4*)(Z + (size_t)row * 512 + 8 * lane);
          float o[8], z[8];
          o[0] = bflo(ov.x); o[1] = bfhi(ov.x); o[2] = bflo(ov.y); o[3] = bfhi(ov.y); o[4] = bflo(ov.z); o[5] = bfhi(ov.z); o[6] = bflo(ov.w); o[7] = bfhi(ov.w);
          z[0] = bflo(zv.x); z[1] = bfhi(zv.x); z[2] = bflo(zv.y); z[3] = bfhi(zv.y); z[4] = bflo(zv.z); z[5] = bfhi(zv.z); z[6] = bflo(zv.w); z[7] = bfhi(zv.w);
          float s = 0.f;
#pragma unroll
          for (int e = 0; e < 8; ++e) s += o[e] * o[e];
          s += __shfl_xor(s, 1); s += __shfl_xor(s, 2); s += __shfl_xor(s, 4); s += __shfl_xor(s, 8);
          const float rs = rsqrtf(s * (1.f / DV) + EPS);
          float r[8];
#pragma unroll
          for (int e = 0; e < 8; ++e) r[e] = o[e] * rs * nw[e] * siluf(z[e]);
          u32x4 w; w.x = pkbf(r[0], r[1]); w.y = pkbf(r[2], r[3]); w.z = pkbf(r[4], r[5]); w.w = pkbf(r[6], r[7]);
          *(u32x4*)(MIX + (size_t)row * D + 8 * lane) = w; }
        const int h = lane >> 3;
        const float l1 = LSE[(size_t)row * 8 + h], l2 = LSE[(size_t)(M + row) * 8 + h], l3 = LSE[(size_t)(2 * M + row) * 8 + h];
        const float mx = fmaxf(l1, fmaxf(l2, l3));
        float w1 = exp2f(l1 - mx), w2 = exp2f(l2 - mx), w3 = exp2f(l3 - mx); const float inv = 1.f / (w1 + w2 + w3); w1 *= inv; w2 *= inv; w3 *= inv;
        const u32x4 a = *(const u32x4*)(O1 + (size_t)row * 512 + 8 * lane), b = *(const u32x4*)(O2 + (size_t)row * 512 + 8 * lane), c = *(const u32x4*)(O3 + (size_t)row * 512 + 8 * lane);
        u32x4 q;
        q.x = pkbf(w1 * bflo(a.x) + w2 * bflo(b.x) + w3 * bflo(c.x), w1 * bfhi(a.x) + w2 * bfhi(b.x) + w3 * bfhi(c.x));
        q.y = pkbf(w1 * bflo(a.y) + w2 * bflo(b.y) + w3 * bflo(c.y), w1 * bfhi(a.y) + w2 * bfhi(b.y) + w3 * bfhi(c.y));
        q.z = pkbf(w1 * bflo(a.z) + w2 * bflo(b.z) + w3 * bflo(c.z), w1 * bfhi(a.z) + w2 * bfhi(b.z) + w3 * bfhi(c.z));
        q.w = pkbf(w1 * bflo(a.w) + w2 * bflo(b.w) + w3 * bflo(c.w), w1 * bfhi(a.w) + w2 * bfhi(b.w) + w3 * bfhi(c.w));
        *(u32x4*)(MIX + (size_t)row * D + 512 + 8 * lane) = q;
    }
}

struct EpiOut {
    static constexpr bool PERM = true, AFTER_DRAIN = false;
    const float* x; float* x1; bf16_t* x1b; float* ssq;
    __device__ __forceinline__ void operator()(const f32x4 (&acc)[2][2][4][2], const pg8::Unit& u, int wr, int wc, int fr, int fq) const {
        const int row0 = u.pm * 256 + wr * 64 + fr, col0 = u.pn * 256 + wc * 32 + 8 * fq;
#pragma unroll
        for (int ai = 0; ai < 2; ++ai)
#pragma unroll
            for (int m = 0; m < 4; ++m) { const int r = row0 + ai * 128 + m * 16; float s = 0.f;
#pragma unroll
                for (int bj = 0; bj < 2; ++bj) { const size_t off = (size_t)r * D + col0 + bj * 128;
                    const f32x4 v0 = *(const f32x4*)(x + off) + acc[ai][bj][m][0], v1 = *(const f32x4*)(x + off + 4) + acc[ai][bj][m][1];
                    u32x4 w; w.x = pkbf(v0[0], v0[1]); w.y = pkbf(v0[2], v0[3]); w.z = pkbf(v1[0], v1[1]); w.w = pkbf(v1[2], v1[3]);
                    *(u32x4*)(x1b + off) = w;
                    s += (v0[0] * v0[0] + v0[1] * v0[1]) + (v0[2] * v0[2] + v0[3] * v0[3]) + (v1[0] * v1[0] + v1[1] * v1[1]) + (v1[2] * v1[2] + v1[3] * v1[3]); }
                s += __shfl_xor(s, 16); s += __shfl_xor(s, 32);
                if (fq == 0) ssq[(size_t)r * 16 + u.pn * 4 + wc] = s; }
    }
};
__device__ __forceinline__ void p5_outproj(Ctx& C) {
    pg8::Gemm g{WSP(bf16_t, WS_MIX), WSP(bf16_t, WS_WOUT), M, D, D}; pg8::StaticOrder S; S.init(M, D, C.G, C.bid);
    EpiOut E{C.x, C.out + O_Y, WSP(bf16_t, WS_X1B), WSP(float, WS_SSQ1)};
    pg8::gemm_phase<EpiOut, pg8::StaticOrder, true, true>(C.lds, g, S, E);
    float* XS1 = WSP(float, WS_XS1); const float* xs = C.xs;
    const ALoadBf16 AL{WSP(bf16_t, WS_SMIX), D};
    auto Ep = [XS1, xs](int row, int col, float v) { XS1[row * D + col] = xs[row * D + col] + v; };
    for (int it = C.bid; it < D / 32; it += C.G) sgemm32_item(it * 32, D, WSP(bf16_t, WS_WOUT), AL, Ep, (LAS float*)C.lds, C.tid);
}

struct EpiUp {
    static constexpr bool PERM = true, AFTER_DRAIN = false;
    bf16_t* H; const float* ssq; int rowoff;
    __device__ __forceinline__ void operator()(const f32x4 (&acc)[2][2][4][2], const pg8::Unit& u, int wr, int wc, int fr, int fq) const {
        const int row0 = rowoff + u.pm * 256 + wr * 64 + fr, col0 = u.pn * 256 + wc * 32 + 8 * fq;
#pragma unroll
        for (int ai = 0; ai < 2; ++ai)
#pragma unroll
            for (int m = 0; m < 4; ++m) { const int r = row0 + ai * 128 + m * 16;
                const f32x4 p = *(const f32x4*)(ssq + (size_t)r * 16 + 4 * fq); float t = (p.x + p.y) + (p.z + p.w);
                t += __shfl_xor(t, 16); t += __shfl_xor(t, 32);
                const float rstd = rsqrtf(t * (1.f / D) + EPS);
#pragma unroll
                for (int bj = 0; bj < 2; ++bj) { f32x4 v0 = acc[ai][bj][m][0] * rstd, v1 = acc[ai][bj][m][1] * rstd;
#pragma unroll
                    for (int e = 0; e < 4; ++e) { const float a = fmaxf(v0[e], 0.f), b = fmaxf(v1[e], 0.f); v0[e] = a * a; v1[e] = b * b; }
                    u32x4 w; w.x = pkbf(v0[0], v0[1]); w.y = pkbf(v0[2], v0[3]); w.z = pkbf(v1[0], v1[1]); w.w = pkbf(v1[2], v1[3]);
                    *(u32x4*)(H + (size_t)r * FF + col0 + bj * 128) = w; } }
    }
};
__device__ __forceinline__ void p6_up(Ctx& C, int half) {
    const int rowoff = half * (M / 2);
    pg8::Gemm g{WSP(bf16_t, WS_X1B) + (size_t)rowoff * D, WSP(bf16_t, WS_WUP), M / 2, FF, D}; pg8::StaticOrder S; S.init(M / 2, FF, C.G, C.bid);
    EpiUp E{WSP(bf16_t, WS_H), WSP(float, WS_SSQ1), rowoff};
    pg8::gemm_phase<EpiUp, pg8::StaticOrder, true, true>(C.lds, g, S, E);
    if (half == 0 && C.bid < FF / 32) {
        bf16_t* SH = WSP(bf16_t, WS_SH);
        const ALoadF32 AL{WSP(float, WS_XS1), D};
        auto Ep = [SH](int row, int col, float v) { const float a = fmaxf(v, 0.f); SH[row * FF + col] = (bf16_t)(pkbf(a * a, 0.f) & 0xffffu); };
        for (int it = C.bid; it < FF / 32; it += C.G) sgemm32_item(it * 32, D, WSP(bf16_t, WS_WUP), AL, Ep, (LAS float*)C.lds, C.tid);
    }
}

struct EpiDown {
    static constexpr bool PERM = true, AFTER_DRAIN = false;
    float* x1; const bf16_t* x1b; float* ssq; unsigned* cnt; const float* lnw; int rowoff;
    __device__ __forceinline__ void operator()(const f32x4 (&acc)[2][2][4][2], const pg8::Unit& u, int wr, int wc, int fr, int fq) const {
        const int row0 = rowoff + u.pm * 256 + wr * 64 + fr, col0 = u.pn * 256 + wc * 32 + 8 * fq;
        f32x4 v[2][4][2][2];
#pragma unroll
        for (int ai = 0; ai < 2; ++ai)
#pragma unroll
            for (int m = 0; m < 4; ++m) { const int r = row0 + ai * 128 + m * 16; float s = 0.f;
#pragma unroll
                for (int bj = 0; bj < 2; ++bj) { const size_t off = (size_t)r * D + col0 + bj * 128;
                    const u32x4 xb = *(const u32x4*)(x1b + off);
                    const f32x4 v0 = (f32x4){bflo(xb.x), bfhi(xb.x), bflo(xb.y), bfhi(xb.y)} + acc[ai][bj][m][0], v1 = (f32x4){bflo(xb.z), bfhi(xb.z), bflo(xb.w), bfhi(xb.w)} + acc[ai][bj][m][1];
                    v[ai][m][bj][0] = v0; v[ai][m][bj][1] = v1;
                    s += (v0[0] * v0[0] + v0[1] * v0[1]) + (v0[2] * v0[2] + v0[3] * v0[3]) + (v1[0] * v1[0] + v1[1] * v1[1]) + (v1[2] * v1[2] + v1[3] * v1[3]); }
                s += __shfl_xor(s, 16); s += __shfl_xor(s, 32);
                if (fq == 0) __hip_atomic_store(ssq + (size_t)r * 16 + u.pn * 4 + wc, s, __ATOMIC_RELAXED, __HIP_MEMORY_SCOPE_AGENT); }
        asm volatile("s_waitcnt vmcnt(0)" ::: "memory");
        unsigned* cp = cnt + 64 * (u.pm + (rowoff >> 8));
        if ((threadIdx.x & 63) == 0) __hip_atomic_fetch_add(cp, 1u, __ATOMIC_RELAXED, __HIP_MEMORY_SCOPE_AGENT);
        { unsigned spins = 0;
          for (;;) { unsigned v = 0u; if ((threadIdx.x & 63) == 0) v = __hip_atomic_load(cp, __ATOMIC_RELAXED, __HIP_MEMORY_SCOPE_AGENT);
              v = (unsigned)__builtin_amdgcn_readfirstlane((int)v); if (v >= 32u || ++spins > (1u << 18)) break; __builtin_amdgcn_s_sleep(8); } }
        __builtin_amdgcn_fence(__ATOMIC_ACQUIRE, "workgroup");
        f32x4 lw[2][2];
#pragma unroll
        for (int bj = 0; bj < 2; ++bj) { lw[bj][0] = *(const f32x4*)(lnw + col0 + bj * 128); lw[bj][1] = *(const f32x4*)(lnw + col0 + bj * 128 + 4); }
#pragma unroll
        for (int ai = 0; ai < 2; ++ai)
#pragma unroll
            for (int m = 0; m < 4; ++m) { const int r = row0 + ai * 128 + m * 16;
                const float* pp = ssq + (size_t)r * 16 + 4 * fq;
                const float p0 = __hip_atomic_load(pp, __ATOMIC_RELAXED, __HIP_MEMORY_SCOPE_AGENT), p1 = __hip_atomic_load(pp + 1, __ATOMIC_RELAXED, __HIP_MEMORY_SCOPE_AGENT),
                            p2 = __hip_atomic_load(pp + 2, __ATOMIC_RELAXED, __HIP_MEMORY_SCOPE_AGENT), p3 = __hip_atomic_load(pp + 3, __ATOMIC_RELAXED, __HIP_MEMORY_SCOPE_AGENT);
                float t = (p0 + p1) + (p2 + p3);
                t += __shfl_xor(t, 16); t += __shfl_xor(t, 32);
                const float rstd = rsqrtf(t * (1.f / D) + EPS);
#pragma unroll
                for (int bj = 0; bj < 2; ++bj) { const size_t off = (size_t)r * D + col0 + bj * 128;
                    *(f32x4*)(x1 + off) = v[ai][m][bj][0] * rstd * lw[bj][0]; *(f32x4*)(x1 + off + 4) = v[ai][m][bj][1] * rstd * lw[bj][1]; } }
    }
};
__device__ __forceinline__ void p7_down(Ctx& C, int half) {
    const int rowoff = half * (M / 2);
    pg8::Gemm g{WSP(bf16_t, WS_H) + (size_t)rowoff * FF, WSP(bf16_t, WS_WDN), M / 2, D, FF}; pg8::StaticOrder S; S.init(M / 2, D, C.G, C.bid);
    EpiDown E{C.out + O_Y, WSP(bf16_t, WS_X1B), WSP(float, WS_SSQ2), (unsigned*)(C.ws + WS_CTL) + CW_PANEL, C.ln_final, rowoff};
    pg8::gemm_phase<EpiDown, pg8::StaticOrder, true, true>(C.lds, g, S, E);
    if (half != 0) return;
    float* SPART = WSP(float, WS_SPART);
    const ALoadBf16 AL{WSP(bf16_t, WS_SH), FF};
    for (int it = C.bid; it < 8 * (D / 32); it += C.G) { const int cg = it & 31, kp = it >> 5;
        auto Ep = [SPART, kp](int row, int col, float v) { SPART[(kp * SB + row) * D + col] = v; };
        sgemm32_part(cg * 32, kp * (FF / 8), FF / 8, FF, WSP(bf16_t, WS_WDN), AL, Ep, (LAS float*)C.lds, C.tid); }
}

__device__ __forceinline__ void p8_final(Ctx& C) {
    const int gw = C.bid * NWAVES + C.wave, NGW = C.G * NWAVES, lane = C.lane;
    f32x4 lw[4];
#pragma unroll
    for (int j = 0; j < 4; ++j) lw[j] = ((const f32x4*)C.ln_final)[64 * j + lane];
    const float* XS1 = WSP(float, WS_XS1); const float* SPART = WSP(float, WS_SPART); float* YS = C.out + O_YS;
    for (int row = gw; row < SB; row += NGW) {
        f32x4 v[4], d[4]; float s1 = 0.f;
#pragma unroll
        for (int j = 0; j < 4; ++j) { v[j] = ((const f32x4*)(XS1 + row * D))[64 * j + lane]; s1 += (v[j].x * v[j].x + v[j].y * v[j].y) + (v[j].z * v[j].z + v[j].w * v[j].w); d[j] = (f32x4){0.f, 0.f, 0.f, 0.f}; }
#pragma unroll
        for (int kp = 0; kp < 8; ++kp)
#pragma unroll
            for (int j = 0; j < 4; ++j) d[j] += ((const f32x4*)(SPART + (size_t)(kp * SB + row) * D))[64 * j + lane];
        s1 = wave_sum(s1); const float r1 = rsqrtf(s1 * (1.f / D) + EPS), r2 = r1 * r1;
        float s = 0.f;
#pragma unroll
        for (int j = 0; j < 4; ++j) { v[j] += d[j] * r2; s += (v[j].x * v[j].x + v[j].y * v[j].y) + (v[j].z * v[j].z + v[j].w * v[j].w); }
        s = wave_sum(s); const float rstd = rsqrtf(s * (1.f / D) + EPS);
#pragma unroll
        for (int j = 0; j < 4; ++j) ((f32x4*)(YS + row * D))[64 * j + lane] = v[j] * rstd * lw[j];
    }
}

#ifndef MK_PER_PHASE
#define MK_PER_PHASE 0
#endif
constexpr int N_PHASES = 9;
struct Args { const float* in[17]; float* out; unsigned char* ws; int ph_lo, ph_hi; };
__global__ void __launch_bounds__(NTHREADS, 2) mk_fwd(Args args) {
    extern __shared__ __attribute__((aligned(16))) unsigned char lds_raw[];
    Ctx C;
    C.lds = (LAS unsigned char*)lds_raw;
    C.tid = threadIdx.x; C.lane = C.tid & 63; C.wave = __builtin_amdgcn_readfirstlane(C.tid >> 6); C.G = gridDim.x; C.bid = blockIdx.x;
    C.x = args.in[0]; C.xs = args.in[1]; C.st_conv = args.in[2]; C.st_ssm = args.in[3]; C.ck = args.in[4]; C.cv = args.in[5]; C.ln_mix = args.in[6]; C.w_in = args.in[7];
    C.conv_w = args.in[8]; C.a_log = args.in[9]; C.dt_bias = args.in[10]; C.dn_norm = args.in[11]; C.w_out = args.in[12]; C.ln_ffn = args.in[13]; C.w_up = args.in[14];
    C.w_dn = args.in[15]; C.ln_final = args.in[16]; C.out = args.out; C.ws = args.ws;
    volatile LAS unsigned* MISC = (volatile LAS unsigned*)(C.lds + MISC_OFF);
    for (int u = C.tid; u < (LDS_BYTES - LDSCTL_OFF) / 4; u += NTHREADS) ((LAS unsigned*)(C.lds + LDSCTL_OFF))[u] = 0u;
    __syncthreads();
    XcdBarrier bar; bar.bar = (unsigned*)(C.ws + WS_CTL) + CW_BAR; bar.x = 0; bar.st = nullptr;
    if (!MK_PER_PHASE) bar = xcd_barrier_post((unsigned*)(C.ws + WS_CTL) + CW_BAR, MISC + 8);
    const int lo = args.ph_lo, hi = args.ph_hi;
#define IN(k) (lo <= (k) && (k) < hi)
#define SEAM(k) do { if (IN(k) && IN((k) + 1)) xcd_barrier(bar); } while (0)
    if (IN(0)) p0_prologue(C);
    SEAM(0);
    if (IN(1)) p1_inproj(C);
    SEAM(1);
    if (IN(2)) p2_mixprep(C);
    SEAM(2);
    if (IN(3)) p3_scan(C);
    SEAM(3);
    if (IN(4)) p4_combine(C);
    SEAM(4);
    if (IN(5)) p5_outproj(C);
    SEAM(5);
    if (IN(6)) p6_up(C, 0);
    SEAM(6);
    if (IN(7)) { p7_down(C, 0); p6_up(C, 1); }
    SEAM(7);
    if (IN(8)) { p7_down(C, 1); p8_final(C); }
#undef IN
#undef SEAM
}

extern "C" void kernel_launch(void* const* d_in, const int* in_sizes, int n_in, void* d_out, int out_size, void* d_ws, size_t ws_size, hipStream_t stream) {
    static int grid = 0;
    if (grid == 0) {
        if (n_in != 17 || (size_t)out_size != O_END || ws_size < WS_END) { fprintf(stderr, "kernel_launch: unexpected shapes (n_in %d out %d ws %zu)\n", n_in, out_size, ws_size); grid = -1; return; }
        int dev = 0, cus = 0;
        if (hipGetDevice(&dev) != hipSuccess || hipDeviceGetAttribute(&cus, hipDeviceAttributeMultiprocessorCount, dev) != hipSuccess) { grid = -1; return; }
        if (hipFuncSetAttribute((const void*)mk_fwd, hipFuncAttributeMaxDynamicSharedMemorySize, LDS_BYTES) != hipSuccess) { fprintf(stderr, "kernel_launch: hipFuncSetAttribute failed\n"); grid = -1; return; }
        int per_cu = 0;
        (void)hipOccupancyMaxActiveBlocksPerMultiprocessor(&per_cu, (const void*)mk_fwd, NTHREADS, LDS_BYTES);
        (void)hipGetLastError();
        grid = cus;
        if (grid != 256) fprintf(stderr, "kernel_launch: note: %d CUs (built for 256)\n", grid);
    }
    if (grid < 0) return;
    (void)hipMemsetAsync((char*)d_ws + WS_CTL, 0, CTL_ZERO_BYTES, stream);
    Args a{};
    for (int i = 0; i < 17; ++i) a.in[i] = (const float*)d_in[i];
    a.out = (float*)d_out; a.ws = (unsigned char*)d_ws;
#if MK_PER_PHASE
    for (int p = 0; p < N_PHASES; ++p) { a.ph_lo = p; a.ph_hi = p + 1; hipLaunchKernelGGL(mk_fwd, dim3(grid), dim3(NTHREADS), LDS_BYTES, stream, a); }
#else
    a.ph_lo = 0; a.ph_hi = N_PHASES; hipLaunchKernelGGL(mk_fwd, dim3(grid), dim3(NTHREADS), LDS_BYTES, stream, a);
#endif
}
```
